# Optimizing an MI355X kernel written in HIP

```python
import math
import jax, jax.numpy as jnp
from jax import lax
import numpy as np

D_MODEL = 1024
BATCH = 8
SEQ = 2048
DEPTH = 1
DEC_BATCH = 128
DEC_SEQ = 8
PAST_LEN = 16384
PAGE_SIZE = 128

MIX_WIDTH = D_MODEL
GLA_WIDTH = MIX_WIDTH // 2
CONV_CH = MIX_WIDTH - GLA_WIDTH
GLA_HEADS = 4
GLA_DV = GLA_WIDTH // GLA_HEADS
GLA_DK = GLA_DV // 2
GLA_KW = GLA_HEADS * GLA_DK
GATE_RANK = 16
GATE_NORM = 16.0
GLA_CHUNK = 16
CONV_K = 3
D_FF = 4 * D_MODEL
N_MOD = 6
EPS = 1e-6
IN_SIZES = (GLA_KW, GLA_KW, GLA_WIDTH, GATE_RANK, GLA_WIDTH, CONV_CH, CONV_CH, CONV_CH)
D_IN_PROJ = 2 * GLA_KW + 2 * GLA_WIDTH + GATE_RANK + 3 * CONV_CH

kernel_name = "hymba_gla_shortconv_adaln_decoder_step"


def rmsnorm(x, g):
    xf = x.astype(jnp.float32)
    y = xf * lax.rsqrt(jnp.mean(xf * xf, axis=-1, keepdims=True) + EPS)
    return (y * g.astype(jnp.float32)).astype(x.dtype)


def gla_recurrence(q, k, v, logd, s0):
    b, L, h, dk = q.shape
    dv = v.shape[-1]
    c = math.gcd(L, GLA_CHUNK)
    n = L // c

    def blocks(t):
        return t.astype(jnp.float32).reshape(b, n, c, h, t.shape[-1]).transpose(1, 0, 3, 2, 4)

    mask = jnp.tril(jnp.ones((c, c), dtype=bool))

    def step(S, inp):
        qc, kc, vc, gc = inp
        cum = jnp.cumsum(gc, axis=-2)
        last = cum[..., -1:, :]
        q_in = qc * jnp.exp(cum)
        k_in = kc * jnp.exp(-cum)
        k_out = kc * jnp.exp(last - cum)
        att = jnp.where(mask, jnp.einsum('bhtd,bhsd->bhts', q_in, k_in), 0.0)
        o = jnp.einsum('bhts,bhsv->bhtv', att, vc) + jnp.einsum('bhtd,bhdv->bhtv', q_in, S)
        S = jnp.exp(last[..., 0, :])[..., None] * S + jnp.einsum('bhsd,bhsv->bhdv', k_out, vc)
        return S, o

    S, o = lax.scan(step, s0.astype(jnp.float32), (blocks(q), blocks(k), blocks(v), blocks(logd)))
    o = o.transpose(1, 0, 3, 2, 4).reshape(b, L, h, dv)
    return o, S


def mixer(h, gla_state, conv_state, w_in, w_gate_up, b_gate, gla_norm_g, w_conv, w_out):
    b, L, _ = h.shape
    proj = h @ w_in
    idx = np.cumsum(IN_SIZES)[:-1].tolist()
    q, k, v, gz, r, bg, cg, hin = jnp.split(proj, idx, axis=-1)
    logd = jax.nn.log_sigmoid((gz @ w_gate_up + b_gate).astype(jnp.float32)) / GATE_NORM
    q = q.reshape(b, L, GLA_HEADS, GLA_DK) * (GLA_DK ** -0.5)
    k = k.reshape(b, L, GLA_HEADS, GLA_DK)
    v = v.reshape(b, L, GLA_HEADS, GLA_DV)
    logd = logd.reshape(b, L, GLA_HEADS, GLA_DK)
    o, gla_new = gla_recurrence(q, k, v, logd, gla_state)
    o = rmsnorm(o.astype(h.dtype), gla_norm_g.reshape(GLA_HEADS, GLA_DV))
    o = o.reshape(b, L, GLA_WIDTH) * jax.nn.silu(r)
    u = cg * hin
    u_full = jnp.concatenate([conv_state.astype(u.dtype), u], axis=1)
    z = sum(w_conv[j] * u_full[:, j:j + L] for j in range(CONV_K))
    yc = bg * z
    conv_new = u_full[:, -(CONV_K - 1):]
    out = jnp.concatenate([o, yc], axis=-1) @ w_out
    return out, gla_new, conv_new


def layer(x, c, gla_state, conv_state, w_ada, b_ada, norm1_g, w_in, w_gate_up, b_gate, gla_norm_g,
          w_conv, w_out, norm2_g, w_up, w_down):
    mod = (jax.nn.silu(c) @ w_ada + b_ada)[:, None, :]
    sh1, sc1, g1, sh2, sc2, g2 = jnp.split(mod, N_MOD, axis=-1)
    h = rmsnorm(x, norm1_g) * (1 + sc1) + sh1
    m, gla_new, conv_new = mixer(h, gla_state, conv_state, w_in, w_gate_up, b_gate, gla_norm_g, w_conv, w_out)
    x = x + g1 * m
    h = rmsnorm(x, norm2_g) * (1 + sc2) + sh2
    f = jnp.square(jax.nn.relu(h @ w_up)) @ w_down
    x = x + g2 * f
    return x, gla_new, conv_new


def setup_inputs(seed: int = 0) -> dict:
    key = jax.random.key(seed)
    ks = jax.random.split(key, 24)
    nrm = lambda k, s, sc: jax.random.normal(k, s, jnp.float32) * sc
    return {
        "x_prompt": nrm(ks[0], (BATCH, SEQ, D_MODEL), 1.0),
        "x_sample": nrm(ks[1], (DEC_BATCH, DEC_SEQ, D_MODEL), 1.0),
        "state_gla": nrm(ks[2], (DEPTH, DEC_BATCH, GLA_HEADS, GLA_DK, GLA_DV), 0.3),
        "state_conv": nrm(ks[3], (DEPTH, DEC_BATCH, CONV_K - 1, CONV_CH), 1.0),
        "c_prompt": nrm(ks[4], (BATCH, D_MODEL), 1.0),
        "c_sample": nrm(ks[5], (DEC_BATCH, D_MODEL), 1.0),
        "w_ada": nrm(ks[6], (DEPTH, D_MODEL, N_MOD * D_MODEL), 0.5 * D_MODEL ** -0.5),
        "b_ada": nrm(ks[7], (DEPTH, N_MOD * D_MODEL), 0.02),
        "norm1_g": 1.0 + nrm(ks[8], (DEPTH, D_MODEL), 0.02),
        "w_in": nrm(ks[9], (DEPTH, D_MODEL, D_IN_PROJ), D_MODEL ** -0.5),
        "w_gate_up": nrm(ks[10], (DEPTH, GATE_RANK, GLA_KW), GATE_RANK ** -0.5),
        "b_gate": nrm(ks[11], (DEPTH, GLA_KW), 0.02),
        "gla_norm_g": 1.0 + nrm(ks[12], (DEPTH, GLA_WIDTH), 0.02),
        "w_conv": nrm(ks[13], (DEPTH, CONV_K, CONV_CH), CONV_K ** -0.5),
        "w_out": nrm(ks[14], (DEPTH, MIX_WIDTH, D_MODEL), MIX_WIDTH ** -0.5),
        "norm2_g": 1.0 + nrm(ks[15], (DEPTH, D_MODEL), 0.02),
        "w_up": nrm(ks[16], (DEPTH, D_MODEL, D_FF), D_MODEL ** -0.5),
        "w_down": nrm(ks[17], (DEPTH, D_FF, D_MODEL), D_FF ** -0.5),
        "final_g": 1.0 + nrm(ks[18], (D_MODEL,), 0.02),
    }


def reference(x_prompt, x_sample, state_gla, state_conv, c_prompt, c_sample, w_ada, b_ada, norm1_g, w_in,
              w_gate_up, b_gate, gla_norm_g, w_conv, w_out, norm2_g, w_up, w_down, final_g):
    xp, xs = x_prompt, x_sample
    bp = x_prompt.shape[0]
    gla_p, conv_p, gla_s, conv_s = [], [], [], []
    for l in range(DEPTH):
        lw = (w_ada[l], b_ada[l], norm1_g[l], w_in[l], w_gate_up[l], b_gate[l], gla_norm_g[l],
              w_conv[l], w_out[l], norm2_g[l], w_up[l], w_down[l])
        zero_gla = jnp.zeros((bp, GLA_HEADS, GLA_DK, GLA_DV), jnp.float32)
        zero_conv = jnp.zeros((bp, CONV_K - 1, CONV_CH), x_prompt.dtype)
        xp, sg, sc = layer(xp, c_prompt, zero_gla, zero_conv, *lw)
        gla_p.append(sg)
        conv_p.append(sc)
        xs, sg, sc = layer(xs, c_sample, state_gla[l], state_conv[l], *lw)
        gla_s.append(sg)
        conv_s.append(sc)
    y_prompt = rmsnorm(xp, final_g)
    y_sample = rmsnorm(xs, final_g)
    new_gla_prompt = jnp.stack(gla_p)
    new_conv_prompt = jnp.stack(conv_p)
    new_gla_sample = jnp.stack(gla_s)
    new_conv_sample = jnp.stack(conv_s)
    return (y_prompt, y_sample, new_gla_prompt, new_conv_prompt, new_gla_sample, new_conv_sample)
```

```cpp
#include <hip/hip_runtime.h>
#include <hip/hip_cooperative_groups.h>
#include <cstdio>
#include <cstdint>
namespace cg = cooperative_groups;
namespace pg8 {
#define PG8_LAS __attribute__((address_space(3)))
typedef unsigned short bf16_t;
typedef short bf16x8 __attribute__((ext_vector_type(8)));
typedef float f32x4 __attribute__((ext_vector_type(4)));
typedef unsigned u32x4 __attribute__((ext_vector_type(4)));
constexpr int BM = 256, BK = 64, HALF = 128, HTB = HALF * BK * 2  , STAGE_BYTES = 8 * HTB, NXCD = 8, WGM = 8;

__host__ __device__ __forceinline__ int lds_byte(int r, int c) { const int st = (r >> 4) * 2 + (c >> 5), rr = r & 15, cc = c & 31, ob = rr * 64 + cc * 2; return st * 1024 + (ob ^ (((ob >> 9) & 1) << 5)); }
__host__ __device__ __forceinline__ void stage_rc(int b, int& R, int& C) { const int st = b / 1024, sb = b % 1024, swz = sb ^ (((sb >> 9) & 1) << 5); R = (st >> 1) * 16 + swz / 64; C = (st & 1) * 32 + (swz % 64) / 2; }
__host__ __device__ __forceinline__ int perm32(int rho) { const int n = rho >> 4, i = rho & 15; return 8 * (i >> 2) + 4 * n + (i & 3); }

struct Unit { int pm, pn, kof; };
struct Gemm { const bf16_t* A; const bf16_t* Bt; int M, N, K, ld; };

struct StaticOrder {
    int nM, nN, nwg, G, c;
    __host__ __device__ void init(int M, int N, int G_, int c_) { nM = M / BM; nN = N / BM; nwg = nM * nN; G = G_; c = c_; }
    __host__ __device__ bool next(int i, Unit& u) const {
        const long L = (long)i * G + c; if (L >= nwg) return false;
        int wgid = (int)L; { const int q = nwg / NXCD, r = nwg % NXCD, xcd = wgid % NXCD, off = wgid / NXCD; wgid = (xcd < r ? xcd * (q + 1) : r * (q + 1) + (xcd - r) * q) + off; }
        const int nig = WGM * nN, gid = wgid / nig, fm = gid * WGM, gsz = (nM - fm) < WGM ? (nM - fm) : WGM;
        u.pm = fm + ((wgid % nig) % gsz); u.pn = (wgid % nig) / gsz; u.kof = 0; return true;
    }
    __device__ __forceinline__ void a_ready(const Unit&) const {}
    __device__ __forceinline__ void done(const Unit&) const {}
};

struct SplitOrder {
    int pm0, nN, nsplit, kslice, nitems, G, c;
    __host__ __device__ void init(int pm0_, int npm, int nN_, int nsplit_, int kslice_, int G_, int c_) { pm0 = pm0_; nN = nN_; nsplit = nsplit_; kslice = kslice_; nitems = npm * nN_ * nsplit_; G = G_; c = c_; }
    __host__ __device__ bool next(int i, Unit& u) const { const long L = (long)i * G + c; if (L >= nitems) return false; const int l = (int)L, ks = l % nsplit, t = l / nsplit; u.pn = t % nN; u.pm = pm0 + t / nN; u.kof = ks * kslice; return true; }
    __device__ __forceinline__ void a_ready(const Unit&) const {}
    __device__ __forceinline__ void done(const Unit&) const {}
};

__device__ __forceinline__ unsigned cvt_pk_bf16(float lo, float hi) { unsigned r; asm volatile("v_cvt_pk_bf16_f32 %0, %1, %2" : "=v"(r) : "v"(lo), "v"(hi)); return r; }
template <class Epi, class Sched, bool ALIGN_EPI = false, bool SP2 = false>
__device__ __forceinline__ void gemm_phase(PG8_LAS unsigned char* lds, const Gemm g, const Sched& S, const Epi& E) {
    const int tid = threadIdx.x, wid = __builtin_amdgcn_readfirstlane(tid >> 6), lane = tid & 63, wr = wid >> 2, wc = wid & 3, fr = lane & 15, fq = lane >> 4;
    const int K = g.ld, nt = g.K / BK;
    unsigned voffA[2], voffB[2];
#pragma unroll
    for (int i = 0; i < 2; ++i) { int R, C; stage_rc(tid * 16 + i * 8192, R, C); const int Rb = Epi::PERM ? ((R & ~31) + perm32(R & 31)) : R;
        voffA[i] = (unsigned)(R * K + C) * 2u; voffB[i] = (unsigned)(Rb * K + C) * 2u; }
    const size_t kstep = (size_t)(BK * 2);
    const size_t hstep = (size_t)HALF * K * 2;
    const size_t tstep = 2 * hstep;
    const unsigned ldsw = (unsigned)wid * 1024u;
    const int aoff = lds_byte(wr * 64 + fr, fq * 8), boff = lds_byte(wc * 32 + fr, fq * 8);
#define PG8_SA(b, h) (((b) * 2 + (h)) * HTB)
#define PG8_SB(b, h) ((4 + (b) * 2 + (h)) * HTB)
#define PG8_STAGE(bufoff, gbase, voff) do { _Pragma("unroll") for (int _i = 0; _i < 2; ++_i) \
        __builtin_amdgcn_global_load_lds((const unsigned*)((const char*)(gbase) + (voff)[_i]), (PG8_LAS unsigned*)(lds + (bufoff) + ldsw + _i * 8192), 16, 0, 0); } while (0)
#define PG8_LDA(dst, b, h) do { _Pragma("unroll") for (int m = 0; m < 4; ++m) _Pragma("unroll") for (int k = 0; k < 2; ++k) dst[m][k] = *(const PG8_LAS bf16x8*)(lds + PG8_SA(b, h) + aoff + m * 2048 + k * 1024); } while (0)
#define PG8_LDB(dst, b, h) do { _Pragma("unroll") for (int n = 0; n < 2; ++n) _Pragma("unroll") for (int k = 0; k < 2; ++k) dst[n][k] = *(const PG8_LAS bf16x8*)(lds + PG8_SB(b, h) + boff + n * 2048 + k * 1024); } while (0)
#define PG8_MMA(ai, bj, At, Bt) do { __builtin_amdgcn_s_setprio(1); _Pragma("unroll") for (int m = 0; m < 4; ++m) _Pragma("unroll") for (int n = 0; n < 2; ++n) _Pragma("unroll") for (int k = 0; k < 2; ++k) \
        acc[ai][bj][m][n] = __builtin_amdgcn_mfma_f32_16x16x32_bf16(Bt[n][k], At[m][k], acc[ai][bj][m][n], 0, 0, 0); __builtin_amdgcn_s_setprio(0); } while (0)
#define PG8_WAIT_V(n) asm volatile("s_waitcnt vmcnt(" #n ")" ::: "memory")
#define PG8_WAIT_L(n) asm volatile("s_waitcnt lgkmcnt(" #n ")" ::: "memory")
#define PG8_BAR __builtin_amdgcn_s_barrier()
#define PG8_SCHED __builtin_amdgcn_sched_barrier(0)
    Unit cur, nxt; int ui = 0;
    if (!S.next(0, cur)) return;
    f32x4 acc[2][2][4][2];
#pragma unroll
    for (int a = 0; a < 2; ++a)
#pragma unroll
        for (int b = 0; b < 2; ++b)
#pragma unroll
            for (int m = 0; m < 4; ++m)
#pragma unroll
                for (int n = 0; n < 2; ++n) acc[a][b][m][n] = (f32x4){0.f, 0.f, 0.f, 0.f};
    bf16x8 At[4][2], B0[2][2], B1[2][2];
    const char* cA = (const char*)g.A + (size_t)cur.pm * tstep + (size_t)cur.kof * 2; const char* cB = (const char*)g.Bt + (size_t)cur.pn * tstep + (size_t)cur.kof * 2;
    S.a_ready(cur);
    if constexpr (SP2) {
        PG8_STAGE(PG8_SB(0, 0), cB, voffB); PG8_STAGE(PG8_SB(0, 1), cB + hstep, voffB); PG8_STAGE(PG8_SA(0, 0), cA, voffA); PG8_STAGE(PG8_SA(0, 1), cA + hstep, voffA);
        if (wr == 1) PG8_BAR;
        PG8_WAIT_V(2); PG8_BAR;
        PG8_STAGE(PG8_SB(1, 0), cB + kstep, voffB); PG8_STAGE(PG8_SA(1, 0), cA + kstep, voffA); PG8_STAGE(PG8_SB(1, 1), cB + hstep + kstep, voffB);
        PG8_WAIT_V(6); PG8_BAR;
    } else {
        PG8_STAGE(PG8_SB(0, 0), cB, voffB); PG8_STAGE(PG8_SA(0, 0), cA, voffA); PG8_STAGE(PG8_SB(0, 1), cB + hstep, voffB); PG8_STAGE(PG8_SA(0, 1), cA + hstep, voffA);
        if (wr == 1) PG8_BAR;
        PG8_WAIT_V(4); PG8_BAR;
        PG8_STAGE(PG8_SB(1, 0), cB + kstep, voffB); PG8_STAGE(PG8_SA(1, 0), cA + kstep, voffA); PG8_STAGE(PG8_SB(1, 1), cB + hstep + kstep, voffB);
        PG8_WAIT_V(6); PG8_BAR;
    }
    for (;;) {
        const bool has_next = S.next(ui + 1, nxt);
        const char* nA = has_next ? (const char*)g.A + (size_t)nxt.pm * tstep + (size_t)nxt.kof * 2 : cA; const char* nB = has_next ? (const char*)g.Bt + (size_t)nxt.pn * tstep + (size_t)nxt.kof * 2 : cB;
        for (int t = 0; t < nt; t += 2) {
            const bool last = (t == nt - 2);
            const char* a1 = cA + (size_t)(t + 1) * kstep;
            const char* a2 = last ? nA : cA + (size_t)(t + 2) * kstep; const char* b2 = last ? nB : cB + (size_t)(t + 2) * kstep;
            const char* a3 = a2 + kstep; const char* b3 = b2 + kstep;
            if (last && has_next) S.a_ready(nxt);
            if constexpr (SP2) {
            PG8_LDB(B0, 0, 0); PG8_LDB(B1, 0, 1); PG8_SCHED; PG8_LDA(At, 0, 0); PG8_STAGE(PG8_SA(1, 1), a1 + hstep, voffA);
            PG8_WAIT_V(8); PG8_WAIT_L(0); PG8_BAR; PG8_MMA(0, 0, At, B0); PG8_MMA(0, 1, At, B1); PG8_BAR; PG8_SCHED;
            PG8_LDA(At, 0, 1); PG8_STAGE(PG8_SB(0, 0), b2, voffB); PG8_STAGE(PG8_SB(0, 1), b2 + hstep, voffB); PG8_STAGE(PG8_SA(0, 0), a2, voffA);
            PG8_WAIT_V(8); PG8_WAIT_L(0); PG8_BAR; PG8_MMA(1, 0, At, B0); PG8_MMA(1, 1, At, B1); PG8_BAR; PG8_SCHED;
            PG8_LDB(B0, 1, 0); PG8_LDB(B1, 1, 1); PG8_SCHED; PG8_LDA(At, 1, 0); PG8_STAGE(PG8_SA(0, 1), a2 + hstep, voffA);
            PG8_WAIT_V(8); PG8_WAIT_L(0); PG8_BAR; PG8_MMA(0, 0, At, B0); PG8_MMA(0, 1, At, B1); PG8_BAR; PG8_SCHED;
            PG8_LDA(At, 1, 1); PG8_STAGE(PG8_SB(1, 0), b3, voffB); PG8_STAGE(PG8_SB(1, 1), b3 + hstep, voffB); PG8_STAGE(PG8_SA(1, 0), a3, voffA);
            PG8_WAIT_V(8); PG8_WAIT_L(0); PG8_BAR; PG8_MMA(1, 0, At, B0); PG8_MMA(1, 1, At, B1); PG8_BAR; PG8_SCHED;
            } else {
            PG8_LDB(B0, 0, 0); PG8_SCHED; PG8_LDA(At, 0, 0); PG8_STAGE(PG8_SA(1, 1), a1 + hstep, voffA);
            PG8_WAIT_L(8); PG8_BAR; PG8_WAIT_L(0); PG8_MMA(0, 0, At, B0); PG8_BAR; PG8_SCHED;
            PG8_LDB(B1, 0, 1); PG8_STAGE(PG8_SB(0, 0), b2, voffB);
            PG8_BAR; PG8_WAIT_L(0); PG8_MMA(0, 1, At, B1); PG8_BAR;
            PG8_LDA(At, 0, 1); PG8_STAGE(PG8_SA(0, 0), a2, voffA);
            PG8_BAR; PG8_WAIT_L(0); PG8_MMA(1, 0, At, B0); PG8_BAR; PG8_SCHED;
            PG8_STAGE(PG8_SB(0, 1), b2 + hstep, voffB);
            PG8_WAIT_V(6); PG8_BAR; PG8_MMA(1, 1, At, B1); PG8_BAR;
            PG8_LDB(B0, 1, 0); PG8_SCHED; PG8_LDA(At, 1, 0); PG8_STAGE(PG8_SA(0, 1), a2 + hstep, voffA);
            PG8_WAIT_L(8); PG8_BAR; PG8_WAIT_L(0); PG8_MMA(0, 0, At, B0); PG8_BAR; PG8_SCHED;
            PG8_LDB(B1, 1, 1); PG8_STAGE(PG8_SB(1, 0), b3, voffB);
            PG8_BAR; PG8_WAIT_L(0); PG8_MMA(0, 1, At, B1); PG8_BAR;
            PG8_LDA(At, 1, 1); PG8_STAGE(PG8_SA(1, 0), a3, voffA);
            PG8_BAR; PG8_WAIT_L(0); PG8_MMA(1, 0, At, B0); PG8_BAR; PG8_SCHED;
            PG8_STAGE(PG8_SB(1, 1), b3 + hstep, voffB);
            PG8_WAIT_V(6); PG8_BAR; PG8_MMA(1, 1, At, B1); PG8_BAR;
            }
        }
        if constexpr (ALIGN_EPI) { if (wr == 0) PG8_BAR; }
        if constexpr (!Epi::AFTER_DRAIN) { E(acc, cur, wr, wc, fr, fq); S.done(cur); }
        if (!has_next) break;
#pragma unroll
        for (int a = 0; a < 2; ++a)
#pragma unroll
            for (int b = 0; b < 2; ++b)
#pragma unroll
                for (int m = 0; m < 4; ++m)
#pragma unroll
                    for (int n = 0; n < 2; ++n) acc[a][b][m][n] = (f32x4){0.f, 0.f, 0.f, 0.f};
        cur = nxt; cA = nA; cB = nB; ++ui;
        if constexpr (ALIGN_EPI) { if (wr == 1) PG8_BAR; }
    }
    PG8_WAIT_V(0);
    if constexpr (!ALIGN_EPI) { if (wr == 0) PG8_BAR; }
    PG8_BAR;
    if constexpr (Epi::AFTER_DRAIN) { E.fused(acc, cur, wr, wc, fr, fq, lds, wid, lane); S.done(cur); }
#undef PG8_SA
#undef PG8_SB
#undef PG8_STAGE
#undef PG8_LDA
#undef PG8_LDB
#undef PG8_MMA
#undef PG8_WAIT_V
#undef PG8_WAIT_L
#undef PG8_BAR
#undef PG8_SCHED
}
}

#define LAS __attribute__((address_space(3)))
typedef unsigned short bf16_t;
typedef short bf16x8 __attribute__((ext_vector_type(8)));
typedef short bf16x4 __attribute__((ext_vector_type(4)));
typedef float f32x4 __attribute__((ext_vector_type(4)));
typedef unsigned u32x4 __attribute__((ext_vector_type(4)));
typedef unsigned u32x2 __attribute__((ext_vector_type(2)));

constexpr int NTHR = 512, NWAVES = 8;
constexpr int D = 1024, MP = 16384, MS = 1024, M = MP + MS, NBATCH = 136, NIN = 3328, FF = 4096, NMOD = 6144;
constexpr int SEQ = 2048, DSEQ = 8;
constexpr float EPS = 1e-6f;
constexpr size_t HM = 524288;
constexpr size_t WS_MOD = 2 * HM, WS_WIN = 10 * HM, WS_WOUT = 24 * HM, WS_WUP = 28 * HM, WS_WDN = 44 * HM, WS_HB = 60 * HM;
constexpr size_t WS_ACT = 128 * HM;
constexpr size_t WS_Q = 128 * HM, WS_K = 145 * HM, WS_V = 162 * HM, WS_R = 196 * HM, WS_BG = 230 * HM, WS_U = 264 * HM, WS_GZ = 298 * HM;
constexpr size_t WS_KOUT = 302 * HM, WS_VT = 318 * HM, WS_SLOC = 350 * HM, WS_DEC = 414 * HM, WS_SLAB = 416 * HM, WS_END = 480 * HM;
static_assert(WS_ACT + (size_t)M * FF * 2 <= 512 * HM && WS_END <= 512 * HM, "workspace map");
constexpr size_t O_Y = 0, O_NGP = (size_t)M * D, O_NCP = O_NGP + 8 * 4 * 64 * 128, O_NGS = O_NCP + 8 * 2 * 512, O_NCS = O_NGS + (size_t)128 * 4 * 64 * 128;
constexpr int LDS_BYTES = 135168, LDS_CTL_OFF = 131072;

struct Params {
    const float* in[19];
    float* out; unsigned char* ws;
    int ph_lo, ph_hi;
};

__device__ __forceinline__ float bf2f(unsigned short b) { return __uint_as_float(((unsigned)b) << 16); }
__device__ __forceinline__ unsigned pk_bf16(float lo, float hi) { return pg8::cvt_pk_bf16(lo, hi); }
__device__ __forceinline__ float wave_sum(float v) {
#pragma unroll
    for (int o = 1; o < 64; o <<= 1) v += __shfl_xor(v, o);
    return v;
}
__device__ __forceinline__ float silu_f(float x) { return x * __builtin_amdgcn_rcpf(1.0f + __expf(-x)); }
__device__ __forceinline__ float logsigmoid_f(float z) { return fminf(z, 0.f) - __logf(1.0f + __expf(-fabsf(z))); }
__device__ __forceinline__ int batch_of_row(int m) { return m < MP ? (m >> 11) : 8 + ((m - MP) >> 3); }
#define LDS_WAIT() asm volatile("s_waitcnt lgkmcnt(0)" ::: "memory")

struct EpiIn {
    static constexpr bool PERM = true, AFTER_DRAIN = false;
    bf16_t *Q, *K, *V, *R, *BG, *U; float* GZ;
    __device__ __forceinline__ void operator()(const f32x4 (&acc)[2][2][4][2], const pg8::Unit& u, int wr, int wc, int fr, int fq) const {
        const int row0 = u.pm * 256 + wr * 64 + fr, cl = wc * 32 + 8 * fq, pn = u.pn;
        if (pn < 8) {
            bf16_t* base; int ldc, colt; float sc = 1.f; bool act = false;
            if (pn == 0) { base = Q; ldc = 256; colt = 0; sc = 0.125f; }
            else if (pn == 1) { base = K; ldc = 256; colt = 0; }
            else if (pn < 4) { base = V; ldc = 512; colt = (pn - 2) * 256; }
            else if (pn < 6) { base = R; ldc = 512; colt = (pn - 4) * 256; act = true; }
            else { base = BG; ldc = 512; colt = (pn - 6) * 256; }
#pragma unroll
            for (int ai = 0; ai < 2; ++ai)
#pragma unroll
                for (int m = 0; m < 4; ++m) { bf16_t* rowp = base + (size_t)(row0 + ai * 128 + m * 16) * ldc + colt + cl;
#pragma unroll
                    for (int bj = 0; bj < 2; ++bj) { f32x4 v0 = acc[ai][bj][m][0] * sc, v1 = acc[ai][bj][m][1] * sc;
                        if (act) {
#pragma unroll
                            for (int j = 0; j < 4; ++j) { v0[j] = silu_f(v0[j]); v1[j] = silu_f(v1[j]); } }
                        u32x4 w; w.x = pk_bf16(v0[0], v0[1]); w.y = pk_bf16(v0[2], v0[3]); w.z = pk_bf16(v1[0], v1[1]); w.w = pk_bf16(v1[2], v1[3]);
                        *(u32x4*)(rowp + bj * 128) = w; } }
        } else if (pn < 12) {
            const int j0 = (pn - 8) * 128 + cl;
#pragma unroll
            for (int ai = 0; ai < 2; ++ai)
#pragma unroll
                for (int m = 0; m < 4; ++m) { bf16_t* rowp = U + (size_t)(row0 + ai * 128 + m * 16) * 512 + j0;
                    const f32x4 v0 = acc[ai][0][m][0] * acc[ai][1][m][0], v1 = acc[ai][0][m][1] * acc[ai][1][m][1];
                    u32x4 w; w.x = pk_bf16(v0[0], v0[1]); w.y = pk_bf16(v0[2], v0[3]); w.z = pk_bf16(v1[0], v1[1]); w.w = pk_bf16(v1[2], v1[3]);
                    *(u32x4*)rowp = w; }
        } else {
            if (wc == 0 && fq < 2) {
#pragma unroll
                for (int ai = 0; ai < 2; ++ai)
#pragma unroll
                    for (int m = 0; m < 4; ++m) { float* rowp = GZ + (size_t)(row0 + ai * 128 + m * 16) * 16 + 8 * fq;
                        *(f32x4*)rowp = acc[ai][0][m][0]; *(f32x4*)(rowp + 4) = acc[ai][0][m][1]; }
            }
        }
    }
};
struct EpiUp {
    static constexpr bool PERM = true, AFTER_DRAIN = false;
    bf16_t* O;
    __device__ __forceinline__ void operator()(const f32x4 (&acc)[2][2][4][2], const pg8::Unit& u, int wr, int wc, int fr, int fq) const {
        const int row0 = u.pm * 256 + wr * 64 + fr, col0 = u.pn * 256 + wc * 32 + 8 * fq;
#pragma unroll
        for (int ai = 0; ai < 2; ++ai)
#pragma unroll
            for (int m = 0; m < 4; ++m) { bf16_t* rowp = O + (size_t)(row0 + ai * 128 + m * 16) * FF + col0;
#pragma unroll
                for (int bj = 0; bj < 2; ++bj) { f32x4 v0 = acc[ai][bj][m][0], v1 = acc[ai][bj][m][1];
#pragma unroll
                    for (int j = 0; j < 4; ++j) { const float a = fmaxf(v0[j], 0.f), b = fmaxf(v1[j], 0.f); v0[j] = a * a; v1[j] = b * b; }
                    u32x4 w; w.x = pk_bf16(v0[0], v0[1]); w.y = pk_bf16(v0[2], v0[3]); w.z = pk_bf16(v1[0], v1[1]); w.w = pk_bf16(v1[2], v1[3]);
                    *(u32x4*)(rowp + bj * 128) = w; } }
    }
};
template <bool FROM_X> struct EpiRes {
    static constexpr bool PERM = false, AFTER_DRAIN = false;
    const float* xp; const float* xs; float* Y; const float* gate;
    __device__ __forceinline__ void operator()(const f32x4 (&acc)[2][2][4][2], const pg8::Unit& u, int wr, int wc, int fr, int fq) const {
        const int row0 = u.pm * 256 + wr * 64 + fr, col0 = u.pn * 256 + wc * 32 + 4 * fq;
#pragma unroll
        for (int ai = 0; ai < 2; ++ai)
#pragma unroll
            for (int m = 0; m < 4; ++m) { const int row = row0 + ai * 128 + m * 16; const int bi = batch_of_row(row);
                const float* gp = gate + (size_t)bi * NMOD + col0; float* yp = Y + (size_t)row * D + col0;
                const float* bp = FROM_X ? ((row < MP ? xp + (size_t)row * D : xs + (size_t)(row - MP) * D) + col0) : (const float*)yp;
#pragma unroll
                for (int bj = 0; bj < 2; ++bj)
#pragma unroll
                    for (int n = 0; n < 2; ++n) { const int o = bj * 128 + n * 16; const f32x4 g = *(const f32x4*)(gp + o), b = *(const f32x4*)(bp + o);
                        *(f32x4*)(yp + o) = b + g * acc[ai][bj][m][n]; }
                asm volatile("" ::: "memory"); }
    }
};

struct EpiSlab {
    static constexpr bool PERM = false, AFTER_DRAIN = false;
    float* S; int kslice;
    __device__ __forceinline__ void operator()(const f32x4 (&acc)[2][2][4][2], const pg8::Unit& u, int wr, int wc, int fr, int fq) const {
        const int row0 = u.pm * 256 - MP + wr * 64 + fr, col0 = u.pn * 256 + wc * 32 + 4 * fq; float* base = S + (size_t)(u.kof / kslice) * MS * D;
#pragma unroll
        for (int ai = 0; ai < 2; ++ai)
#pragma unroll
            for (int m = 0; m < 4; ++m) { float* yp = base + (size_t)(row0 + ai * 128 + m * 16) * D + col0;
#pragma unroll
                for (int bj = 0; bj < 2; ++bj)
#pragma unroll
                    for (int n = 0; n < 2; ++n) *(f32x4*)(yp + bj * 128 + n * 16) = acc[ai][bj][m][n]; }
    }
};

__device__ __forceinline__ void tr_item(const float* W, int ldn, int Kdim, int k0, int n0src, int nvalid, bf16_t* WT, int n0dst, LAS float* scr, int lane) {
    const int nn = lane & 31;
#pragma unroll 8
    for (int i = 0; i < 32; ++i) { const int kk = 2 * i + (lane >> 5); scr[kk * 33 + nn] = (nn < nvalid) ? W[(size_t)(k0 + kk) * ldn + n0src + nn] : 0.f; }
    LDS_WAIT();
    const int c = lane & 7;
#pragma unroll
    for (int j = 0; j < 4; ++j) { const int n = (lane >> 3) + 8 * j; const LAS float* s = scr + (8 * c) * 33 + n;
        u32x4 o; o.x = pk_bf16(s[0 * 33], s[1 * 33]); o.y = pk_bf16(s[2 * 33], s[3 * 33]); o.z = pk_bf16(s[4 * 33], s[5 * 33]); o.w = pk_bf16(s[6 * 33], s[7 * 33]);
        *(u32x4*)(WT + (size_t)(n0dst + n) * Kdim + k0 + 8 * c) = o; }
    LDS_WAIT();
}
__device__ __forceinline__ void win_map(int vc0, int& src, int& nvalid) {
    nvalid = 32;
    if (vc0 < 1024) src = vc0;
    else if (vc0 < 2048) src = vc0 + 16;
    else if (vc0 < 3072) { const int j = (vc0 - 2048) >> 8, w = (vc0 - 2048) & 255; src = (w < 128) ? (2064 + 128 * j + w) : (2576 + 128 * j + (w - 128)); }
    else { src = 1024 + (vc0 - 3072); nvalid = (vc0 == 3072) ? 16 : 0; if (nvalid == 0) src = 0; }
}
__device__ __forceinline__ void phase_prep(const Params& p, LAS unsigned char* lds, int tid, int wave, int lane) {
    const int G = gridDim.x;
    unsigned char* ws = p.ws;
    {
        LAS float* CS = (LAS float*)lds;
        LAS float* PART = (LAS float*)(lds + 17 * 1024 * 4);
        const float* w_ada = p.in[6]; const float* b_ada = p.in[7]; float* MOD = (float*)(ws + WS_MOD);
        int cur_rg = -1;
        for (int it = blockIdx.x; it < 768; it += G) {
            const int rg = it & 7, cb = it >> 3;
            if (rg != cur_rg) {
                __syncthreads();
                for (int idx = tid; idx < 17 * 1024; idx += NTHR) { const int r = idx >> 10, k = idx & 1023, bi = rg * 17 + r;
                    const float cv = bi < 8 ? p.in[4][bi * 1024 + k] : p.in[5][(bi - 8) * 1024 + k]; CS[idx] = silu_f(cv); }
                cur_rg = rg;
                __syncthreads();
            }
            float acc[17];
#pragma unroll
            for (int r = 0; r < 17; ++r) acc[r] = 0.f;
            const float* wp = w_ada + (size_t)(wave * 128) * NMOD + cb * 64 + lane;
            float wv[2][16];
#pragma unroll
            for (int j = 0; j < 16; ++j) wv[0][j] = wp[(size_t)j * NMOD];
#pragma unroll
            for (int kb = 0; kb < 8; ++kb) {
                if (kb < 7) {
#pragma unroll
                    for (int j = 0; j < 16; ++j) wv[(kb + 1) & 1][j] = wp[(size_t)((kb + 1) * 16 + j) * NMOD]; }
#pragma unroll
                for (int q = 0; q < 4; ++q)
#pragma unroll
                    for (int r = 0; r < 17; ++r) { const f32x4 c4 = *(const LAS f32x4*)(CS + r * 1024 + wave * 128 + kb * 16 + 4 * q);
                        acc[r] += c4[0] * wv[kb & 1][4 * q] + c4[1] * wv[kb & 1][4 * q + 1] + c4[2] * wv[kb & 1][4 * q + 2] + c4[3] * wv[kb & 1][4 * q + 3]; }
            }
#pragma unroll
            for (int r = 0; r < 17; ++r) PART[(wave * 17 + r) * 64 + lane] = acc[r];
            __syncthreads();
            for (int idx = tid; idx < 17 * 64; idx += NTHR) { const int r = idx >> 6, l = idx & 63; float s = b_ada[cb * 64 + l];
#pragma unroll
                for (int w = 0; w < 8; ++w) s += PART[(w * 17 + r) * 64 + l];
                MOD[(size_t)(rg * 17 + r) * NMOD + cb * 64 + l] = s; }
            __syncthreads();
        }
        __syncthreads();
    }
    {
        LAS float* scr = (LAS float*)(lds + wave * 16384);
        const int gw = blockIdx.x * NWAVES + wave, NGW = G * NWAVES;
        constexpr int I_IN = 16 * (NIN / 32), I_OUT = 16 * 32, I_UP = 16 * 128, I_DN = 64 * 32;
        for (int it = gw; it < I_IN + I_OUT + I_UP + I_DN; it += NGW) {
            int r = it;
            if (r < I_IN) { const int nb = r % (NIN / 32), kb = r / (NIN / 32); int src, nv; win_map(nb * 32, src, nv);
                tr_item(p.in[9], 3088, D, kb * 64, src, nv, (bf16_t*)(ws + WS_WIN), nb * 32, scr, lane); continue; } r -= I_IN;
            if (r < I_OUT) { const int nb = r % 32, kb = r / 32; tr_item(p.in[14], D, D, kb * 64, nb * 32, 32, (bf16_t*)(ws + WS_WOUT), nb * 32, scr, lane); continue; } r -= I_OUT;
            if (r < I_UP) { const int nb = r % 128, kb = r / 128; tr_item(p.in[16], FF, D, kb * 64, nb * 32, 32, (bf16_t*)(ws + WS_WUP), nb * 32, scr, lane); continue; } r -= I_UP;
            { const int nb = r % 32, kb = r / 32; tr_item(p.in[17], D, FF, kb * 64, nb * 32, 32, (bf16_t*)(ws + WS_WDN), nb * 32, scr, lane); }
        }
    }
}

__device__ __forceinline__ void norm_mod_vals(const f32x4 (&v)[4], const float* g, const float* sc, const float* sh, bf16_t* orow, int lane) {
    float s = 0.f;
#pragma unroll
    for (int j = 0; j < 4; ++j) s += (v[j][0] * v[j][0] + v[j][1] * v[j][1]) + (v[j][2] * v[j][2] + v[j][3] * v[j][3]);
    const float rstd = 1.0f / sqrtf(wave_sum(s) * (1.f / D) + EPS);
    unsigned long long* o8 = (unsigned long long*)orow + lane;
#pragma unroll
    for (int j = 0; j < 4; ++j) { const f32x4 gg = ((const f32x4*)g)[lane + 64 * j], ss = ((const f32x4*)sc)[lane + 64 * j], hh = ((const f32x4*)sh)[lane + 64 * j];
        const f32x4 y = (v[j] * rstd * gg) * (ss + 1.0f) + hh;
        o8[64 * j] = (unsigned long long)pk_bf16(y[0], y[1]) | ((unsigned long long)pk_bf16(y[2], y[3]) << 32); }
}

template <int NS> __device__ __forceinline__ void slab_row(const float* base, const float* gate, const float* slab, int r, int lane, f32x4 (&v)[4]) {
#pragma unroll
    for (int j = 0; j < 4; ++j) { f32x4 a = ((const f32x4*)(slab + (size_t)r * D))[lane + 64 * j];
#pragma unroll
        for (int ks = 1; ks < NS; ++ks) a += ((const f32x4*)(slab + ((size_t)ks * MS + r) * D))[lane + 64 * j];
        v[j] = ((const f32x4*)base)[lane + 64 * j] + ((const f32x4*)gate)[lane + 64 * j] * a; }
}
__device__ __forceinline__ void gla_decay_item(const Params& p, int it, int lane) {
    unsigned char* ws = p.ws;
    const int b = it >> 7, h = (it >> 5) & 3, c = it & 31, m0 = b * SEQ + c * 64, col = h * 64 + lane;
    const float* GZ = (const float*)(ws + WS_GZ); bf16_t* Q = (bf16_t*)(ws + WS_Q); bf16_t* K = (bf16_t*)(ws + WS_K); bf16_t* KOUT = (bf16_t*)(ws + WS_KOUT);
    float wg[16];
#pragma unroll
    for (int r = 0; r < 16; ++r) wg[r] = p.in[10][r * 256 + col];
    const float bgt = p.in[11][col];
    float last = 0.f;
#pragma unroll 4
    for (int t = 0; t < 64; ++t) {
        const float* gz = GZ + (size_t)(m0 + t) * 16; float z = bgt;
#pragma unroll
        for (int r = 0; r < 16; ++r) z += gz[r] * wg[r];
        last += logsigmoid_f(z) * (1.0f / 16.0f);
    }
    float run = 0.f;
#pragma unroll 1
    for (int tb = 0; tb < 8; ++tb) {
        float ko[8];
#pragma unroll
        for (int j = 0; j < 8; ++j) { const int t = tb * 8 + j; const size_t o = (size_t)(m0 + t) * 256 + col;
            const float* gz = GZ + (size_t)(m0 + t) * 16; float z = bgt;
#pragma unroll
            for (int r = 0; r < 16; ++r) z += gz[r] * wg[r];
            run += logsigmoid_f(z) * (1.0f / 16.0f);
            const float q = bf2f(Q[o]), k = bf2f(K[o]);
            const float qi = q * __expf(run), ki = k * __expf(-run); ko[j] = k * __expf(last - run);
            Q[o] = (bf16_t)(pk_bf16(qi, 0.f) & 0xffffu); K[o] = (bf16_t)(pk_bf16(ki, 0.f) & 0xffffu); }
        u32x4 w; w.x = pk_bf16(ko[0], ko[1]); w.y = pk_bf16(ko[2], ko[3]); w.z = pk_bf16(ko[4], ko[5]); w.w = pk_bf16(ko[6], ko[7]);
        *(u32x4*)(KOUT + ((size_t)it * 64 + lane) * 64 + tb * 8) = w;
    }
    ((float*)(ws + WS_DEC))[(size_t)it * 64 + lane] = __expf(last);
}
__device__ __forceinline__ void gla_vt_item(const Params& p, int it2, int lane) {
    unsigned char* ws = p.ws;
    const int it = it2 >> 1, vh = it2 & 1, b = it >> 7, h = (it >> 5) & 3, c = it & 31, m0 = b * SEQ + c * 64, v = vh * 64 + lane;
    const bf16_t* V = (const bf16_t*)(ws + WS_V) + (size_t)m0 * 512 + h * 128 + v; bf16_t* VT = (bf16_t*)(ws + WS_VT) + ((size_t)it * 128 + v) * 64;
#pragma unroll
    for (int sb = 0; sb < 8; ++sb) { unsigned short e[8];
#pragma unroll
        for (int j = 0; j < 8; ++j) e[j] = V[(size_t)(sb * 8 + j) * 512];
        u32x4 w; w.x = e[0] | ((unsigned)e[1] << 16); w.y = e[2] | ((unsigned)e[3] << 16); w.z = e[4] | ((unsigned)e[5] << 16); w.w = e[6] | ((unsigned)e[7] << 16);
        *(u32x4*)(VT + sb * 8) = w; }
}
__device__ __forceinline__ void gla_sample_item(const Params& p, int its, LAS float* L, int lane) {
    unsigned char* ws = p.ws;
    const int b = its >> 2, h = its & 3, mrow = MP + b * DSEQ;
    const float* GZ = (const float*)(ws + WS_GZ); const bf16_t* Q = (const bf16_t*)(ws + WS_Q); const bf16_t* K = (const bf16_t*)(ws + WS_K);
    const bf16_t* V = (const bf16_t*)(ws + WS_V); const bf16_t* R = (const bf16_t*)(ws + WS_R); bf16_t* HB = (bf16_t*)(ws + WS_HB);
    {
        const int col = h * 64 + lane; float wg[16];
#pragma unroll
        for (int r = 0; r < 16; ++r) wg[r] = p.in[10][r * 256 + col];
        const float bgt = p.in[11][col];
#pragma unroll
        for (int t = 0; t < 8; ++t) { const float* gz = GZ + (size_t)(mrow + t) * 16; float z = bgt;
#pragma unroll
            for (int r = 0; r < 16; ++r) z += gz[r] * wg[r];
            const float ld = logsigmoid_f(z) * (1.0f / 16.0f); const size_t o = (size_t)(mrow + t) * 256 + col;
            L[t * 64 + lane] = __expf(ld); L[512 + t * 64 + lane] = bf2f(K[o]); L[1024 + t * 64 + lane] = bf2f(Q[o]); }
        LDS_WAIT();
    }
    const float* S0p = p.in[2] + (size_t)its * 64 * 128; float* So = p.out + O_NGS + (size_t)its * 64 * 128;
#pragma unroll 1
    for (int hf = 0; hf < 2; ++hf) {
        float s0[64];
#pragma unroll
        for (int d = 0; d < 64; ++d) { const float* sp = S0p + hf * 64 + lane + (d >> 3) * 1024; if ((d & 7) == 0) asm volatile("" : "+v"(sp)); s0[d] = sp[(d & 7) * 128]; }
#pragma unroll 1
        for (int t = 0; t < 8; ++t) {
            const float v0 = bf2f(V[(size_t)(mrow + t) * 512 + h * 128 + hf * 64 + lane]); float o0 = 0.f;
#pragma unroll
            for (int d4 = 0; d4 < 16; ++d4) { const f32x4 a = *(const LAS f32x4*)(L + t * 64 + 4 * d4), k = *(const LAS f32x4*)(L + 512 + t * 64 + 4 * d4), q = *(const LAS f32x4*)(L + 1024 + t * 64 + 4 * d4);
#pragma unroll
                for (int j = 0; j < 4; ++j) { const int d = 4 * d4 + j; s0[d] = a[j] * s0[d] + k[j] * v0; o0 += q[j] * s0[d]; } }
            L[1536 + (hf * 8 + t) * 64 + lane] = o0;
        }
#pragma unroll
        for (int d = 0; d < 64; ++d) { float* sp = So + hf * 64 + lane + (d >> 3) * 1024; if ((d & 7) == 0) asm volatile("" : "+v"(sp)); sp[(d & 7) * 128] = s0[d]; }
    }
    LDS_WAIT();
    const float gn0 = p.in[12][h * 128 + lane], gn1 = p.in[12][h * 128 + 64 + lane];
#pragma unroll 1
    for (int t = 0; t < 8; ++t) {
        const float o0 = L[1536 + t * 64 + lane], o1 = L[1536 + (8 + t) * 64 + lane];
        const float rstd = 1.0f / sqrtf(wave_sum(o0 * o0 + o1 * o1) * (1.f / 128.f) + EPS);
        const size_t vo = (size_t)(mrow + t) * 512 + h * 128 + lane;
        const float r0 = bf2f(R[vo]), r1 = bf2f(R[vo + 64]);
        bf16_t* hp = HB + (size_t)(mrow + t) * D + h * 128 + lane;
        hp[0] = (bf16_t)(pk_bf16(o0 * rstd * gn0 * r0, 0.f) & 0xffffu); hp[64] = (bf16_t)(pk_bf16(o1 * rstd * gn1 * r1, 0.f) & 0xffffu);
    }
    LDS_WAIT();
}
__device__ __forceinline__ void conv_row(const Params& p, int m, int lane) {
    unsigned char* ws = p.ws;
    const bf16_t* U = (const bf16_t*)(ws + WS_U); const bf16_t* BG = (const bf16_t*)(ws + WS_BG); bf16_t* HB = (bf16_t*)(ws + WS_HB);
    const int ch = 8 * lane; const bool prompt = m < MP; const int t = prompt ? (m & (SEQ - 1)) : ((m - MP) & (DSEQ - 1)); const int b = prompt ? (m >> 11) : ((m - MP) >> 3);
    const int L = prompt ? SEQ : DSEQ;
    float u0[8], u1[8], u2[8], bg[8];
    { const u32x4 w = *(const u32x4*)(U + (size_t)m * 512 + ch); const u32x4 g = *(const u32x4*)(BG + (size_t)m * 512 + ch);
#pragma unroll
      for (int j = 0; j < 4; ++j) { u0[2 * j] = __uint_as_float(w[j] << 16); u0[2 * j + 1] = __uint_as_float(w[j] & 0xffff0000u); bg[2 * j] = __uint_as_float(g[j] << 16); bg[2 * j + 1] = __uint_as_float(g[j] & 0xffff0000u); } }
    const float* st = p.in[3] + (size_t)b * 2 * 512 + ch;
    if (t >= 1) { const u32x4 w = *(const u32x4*)(U + (size_t)(m - 1) * 512 + ch);
#pragma unroll
        for (int j = 0; j < 4; ++j) { u1[2 * j] = __uint_as_float(w[j] << 16); u1[2 * j + 1] = __uint_as_float(w[j] & 0xffff0000u); } }
    else {
#pragma unroll
        for (int j = 0; j < 8; ++j) u1[j] = prompt ? 0.f : st[512 + j]; }
    if (t >= 2) { const u32x4 w = *(const u32x4*)(U + (size_t)(m - 2) * 512 + ch);
#pragma unroll
        for (int j = 0; j < 4; ++j) { u2[2 * j] = __uint_as_float(w[j] << 16); u2[2 * j + 1] = __uint_as_float(w[j] & 0xffff0000u); } }
    else {
#pragma unroll
        for (int j = 0; j < 8; ++j) u2[j] = prompt ? 0.f : st[(t == 1 ? 512 : 0) + j]; }
    const float* wc = p.in[13] + ch; float y[8];
#pragma unroll
    for (int j = 0; j < 8; ++j) y[j] = bg[j] * (wc[j] * u2[j] + wc[512 + j] * u1[j] + wc[1024 + j] * u0[j]);
    u32x4 o; o.x = pk_bf16(y[0], y[1]); o.y = pk_bf16(y[2], y[3]); o.z = pk_bf16(y[4], y[5]); o.w = pk_bf16(y[6], y[7]);
    *(u32x4*)(HB + (size_t)m * D + 512 + ch) = o;
    if (t == L - 1) { float* nc = p.out + (prompt ? O_NCP : O_NCS) + (size_t)b * 2 * 512 + ch;
#pragma unroll
        for (int j = 0; j < 8; ++j) { nc[j] = u1[j]; nc[512 + j] = u0[j]; } }
}
__device__ __forceinline__ void gla_sloc_item(const Params& p, int it2, int lane) {
    unsigned char* ws = p.ws;
    const int it = it2 >> 1, vh = it2 & 1, fr = lane & 15, fq = lane >> 4;
    const bf16_t* VT = (const bf16_t*)(ws + WS_VT) + ((size_t)it * 128 + vh * 64) * 64; const bf16_t* KO = (const bf16_t*)(ws + WS_KOUT) + (size_t)it * 64 * 64;
    f32x4 acc[4][4];
#pragma unroll
    for (int a = 0; a < 4; ++a)
#pragma unroll
        for (int b = 0; b < 4; ++b) acc[a][b] = (f32x4){0.f, 0.f, 0.f, 0.f};
#pragma unroll
    for (int ks = 0; ks < 2; ++ks) { bf16x8 A[4], B[4];
#pragma unroll
        for (int i = 0; i < 4; ++i) { A[i] = *(const bf16x8*)(VT + (size_t)(16 * i + fr) * 64 + 32 * ks + 8 * fq); B[i] = *(const bf16x8*)(KO + (size_t)(16 * i + fr) * 64 + 32 * ks + 8 * fq); }
#pragma unroll
        for (int a = 0; a < 4; ++a)
#pragma unroll
            for (int b = 0; b < 4; ++b) acc[a][b] = __builtin_amdgcn_mfma_f32_16x16x32_bf16(A[a], B[b], acc[a][b], 0, 0, 0); }
    float* SL = (float*)(ws + WS_SLOC) + ((size_t)it * 128 + vh * 64) * 64;
#pragma unroll
    for (int a = 0; a < 4; ++a)
#pragma unroll
        for (int b = 0; b < 4; ++b)
#pragma unroll
            for (int i = 0; i < 4; ++i) SL[(size_t)(16 * a + 4 * fq + i) * 64 + 16 * b + fr] = acc[a][b][i];
}
__device__ __forceinline__ void gla_scan(const Params& p, int tid) {
    unsigned char* ws = p.ws;
    f32x4* SL = (f32x4*)(ws + WS_SLOC); const f32x4* DEC = (const f32x4*)(ws + WS_DEC);
    for (int idx = blockIdx.x * NTHR + tid; idx < 32 * 128 * 16; idx += gridDim.x * NTHR) {
        const int bh = idx >> 11, v = (idx >> 4) & 127, d4 = idx & 15;
        f32x4 S = (f32x4){0.f, 0.f, 0.f, 0.f};
#pragma unroll 8
        for (int c = 0; c < 32; ++c) { const size_t o = ((size_t)(bh * 32 + c) * 128 + v) * 16 + d4; const f32x4 t = SL[o], dc = DEC[(size_t)(bh * 32 + c) * 16 + d4]; SL[o] = S; S = dc * S + t; }
        float* ng = p.out + O_NGP + (size_t)bh * 64 * 128 + v;
#pragma unroll
        for (int i = 0; i < 4; ++i) ng[(size_t)(4 * d4 + i) * 128] = S[i];
    }
}
__device__ __forceinline__ void gla_out_item(const Params& p, int it2, int lane) {
    unsigned char* ws = p.ws;
    const int it = it2 >> 1, th = it2 & 1, fr = lane & 15, fq = lane >> 4;
    const int b = it >> 7, h = (it >> 5) & 3, c = it & 31, m0 = b * SEQ + c * 64;
    const bf16_t* Q = (const bf16_t*)(ws + WS_Q) + (size_t)m0 * 256 + h * 64; const bf16_t* K = (const bf16_t*)(ws + WS_K) + (size_t)m0 * 256 + h * 64;
    const bf16_t* VT = (const bf16_t*)(ws + WS_VT) + (size_t)it * 128 * 64; const float* ST = (const float*)(ws + WS_SLOC) + (size_t)it * 128 * 64;
    bf16x8 Bq[2][2];
#pragma unroll
    for (int tt = 0; tt < 2; ++tt)
#pragma unroll
        for (int ks = 0; ks < 2; ++ks) Bq[tt][ks] = *(const bf16x8*)(Q + (size_t)(32 * th + 16 * tt + fr) * 256 + 32 * ks + 8 * fq);
    u32x2 P[4][2];
#pragma unroll
    for (int st = 0; st < 4; ++st) {
        if (st < 2 + 2 * th) {
            f32x4 a0 = (f32x4){0.f, 0.f, 0.f, 0.f}, a1 = a0;
#pragma unroll
            for (int ks = 0; ks < 2; ++ks) { const bf16x8 Ak = *(const bf16x8*)(K + (size_t)(16 * st + fr) * 256 + 32 * ks + 8 * fq);
                a0 = __builtin_amdgcn_mfma_f32_16x16x32_bf16(Ak, Bq[0][ks], a0, 0, 0, 0); a1 = __builtin_amdgcn_mfma_f32_16x16x32_bf16(Ak, Bq[1][ks], a1, 0, 0, 0); }
            const int t0 = 32 * th + fr, t1 = t0 + 16;
#pragma unroll
            for (int i = 0; i < 4; ++i) { const int s = 16 * st + 4 * fq + i; a0[i] = (s <= t0) ? a0[i] : 0.f; a1[i] = (s <= t1) ? a1[i] : 0.f; }
            P[st][0].x = pk_bf16(a0[0], a0[1]); P[st][0].y = pk_bf16(a0[2], a0[3]); P[st][1].x = pk_bf16(a1[0], a1[1]); P[st][1].y = pk_bf16(a1[2], a1[3]);
        } else { P[st][0] = (u32x2){0u, 0u}; P[st][1] = (u32x2){0u, 0u}; }
    }
    f32x4 acc[8][2];
#pragma unroll
    for (int vt = 0; vt < 8; ++vt) { acc[vt][0] = (f32x4){0.f, 0.f, 0.f, 0.f}; acc[vt][1] = acc[vt][0]; }
#pragma unroll
    for (int kp = 0; kp < 2; ++kp) {
        if (kp < 1 + th) {
            bf16x8 Bp[2];
#pragma unroll
            for (int tt = 0; tt < 2; ++tt) { u32x4 w; w.x = P[2 * kp][tt].x; w.y = P[2 * kp][tt].y; w.z = P[2 * kp + 1][tt].x; w.w = P[2 * kp + 1][tt].y; Bp[tt] = __builtin_bit_cast(bf16x8, w); }
#pragma unroll
            for (int vt = 0; vt < 8; ++vt) { const bf16_t* vp = VT + (size_t)(16 * vt + fr) * 64 + 32 * kp + 4 * fq;
                const u32x2 lo = *(const u32x2*)vp, hi = *(const u32x2*)(vp + 16); u32x4 w; w.x = lo.x; w.y = lo.y; w.z = hi.x; w.w = hi.y; const bf16x8 Av = __builtin_bit_cast(bf16x8, w);
                acc[vt][0] = __builtin_amdgcn_mfma_f32_16x16x32_bf16(Av, Bp[0], acc[vt][0], 0, 0, 0); acc[vt][1] = __builtin_amdgcn_mfma_f32_16x16x32_bf16(Av, Bp[1], acc[vt][1], 0, 0, 0); }
        }
    }
#pragma unroll
    for (int ks = 0; ks < 2; ++ks)
#pragma unroll
        for (int vt = 0; vt < 8; ++vt) { const float* sp = ST + (size_t)(16 * vt + fr) * 64 + 32 * ks + 8 * fq; const f32x4 s0 = *(const f32x4*)sp, s1 = *(const f32x4*)(sp + 4);
            u32x4 w; w.x = pk_bf16(s0[0], s0[1]); w.y = pk_bf16(s0[2], s0[3]); w.z = pk_bf16(s1[0], s1[1]); w.w = pk_bf16(s1[2], s1[3]); const bf16x8 As = __builtin_bit_cast(bf16x8, w);
            acc[vt][0] = __builtin_amdgcn_mfma_f32_16x16x32_bf16(As, Bq[0][ks], acc[vt][0], 0, 0, 0); acc[vt][1] = __builtin_amdgcn_mfma_f32_16x16x32_bf16(As, Bq[1][ks], acc[vt][1], 0, 0, 0); }
    const bf16_t* R = (const bf16_t*)(ws + WS_R); bf16_t* HB = (bf16_t*)(ws + WS_HB); const float* gn = p.in[12] + h * 128;
#pragma unroll
    for (int tt = 0; tt < 2; ++tt) { float ss = 0.f;
#pragma unroll
        for (int vt = 0; vt < 8; ++vt) ss += (acc[vt][tt][0] * acc[vt][tt][0] + acc[vt][tt][1] * acc[vt][tt][1]) + (acc[vt][tt][2] * acc[vt][tt][2] + acc[vt][tt][3] * acc[vt][tt][3]);
        ss += __shfl_xor(ss, 16); ss += __shfl_xor(ss, 32);
        const float rstd = 1.0f / sqrtf(ss * (1.f / 128.f) + EPS);
        const int mrow = m0 + 32 * th + 16 * tt + fr;
#pragma unroll
        for (int vt = 0; vt < 8; ++vt) { const int v = 16 * vt + 4 * fq; const f32x4 g4 = *(const f32x4*)(gn + v); const u32x2 rw = *(const u32x2*)(R + (size_t)mrow * 512 + h * 128 + v);
            const float r0 = __uint_as_float(rw.x << 16), r1 = __uint_as_float(rw.x & 0xffff0000u), r2 = __uint_as_float(rw.y << 16), r3 = __uint_as_float(rw.y & 0xffff0000u);
            const f32x4 o = acc[vt][tt] * rstd * g4;
            u32x2 w; w.x = pk_bf16(o[0] * r0, o[1] * r1); w.y = pk_bf16(o[2] * r2, o[3] * r3);
            *(u32x2*)(HB + (size_t)mrow * D + h * 128 + v) = w; }
    }
}

#define RLX_AGENT __ATOMIC_RELAXED, __HIP_MEMORY_SCOPE_AGENT
#define XB_TMO      128
#define XB_XCNT(j)  (256  + 64 * (j))
#define XB_XSUB(j)  (1280 + 64 * (j))
#define XB_XGEN(j)  (2304 + 64 * (j))
#define XB_TOP      3328
#define XB_TOPGEN   3392
#define XCD_BAR_WORDS 3456
#define XB_SPIN_CAP (1u << 18)

__device__ __forceinline__ unsigned xb_ld(unsigned* p)              { return __hip_atomic_load(p, __ATOMIC_RELAXED, __HIP_MEMORY_SCOPE_AGENT); }
__device__ __forceinline__ unsigned xb_add(unsigned* p, unsigned v) { return __hip_atomic_fetch_add(p, v, __ATOMIC_RELAXED, __HIP_MEMORY_SCOPE_AGENT); }
__device__ __forceinline__ unsigned xb_xcc_id() { return (unsigned)__builtin_amdgcn_s_getreg((3 << 11) | 20) & 0xFu; }
#define XB_SPIN(cond, bar) do { unsigned _sp = 0; while (cond) { __builtin_amdgcn_s_sleep(1); \
    if ((++_sp & 255u) == 0u) { if (xb_ld(&(bar)[XB_TMO])) break; if (_sp > XB_SPIN_CAP) { atomicAdd(&(bar)[XB_TMO], 1u); break; } } } } while (0)

struct XcdBarrier {
    unsigned* bar; unsigned x;
    volatile LAS unsigned* st;
};

__device__ __forceinline__ XcdBarrier xcd_barrier_post(unsigned* bar, volatile LAS unsigned* st) {
    XcdBarrier b; b.bar = bar; b.x = xb_xcc_id(); b.st = st;
    if (threadIdx.x == 0) (void)xb_add(&bar[XB_XCNT(b.x)], 1u);
    return b;
}
__device__ __forceinline__ void xcd_barrier_complete(unsigned* bar, unsigned x, unsigned& nloc, unsigned& nx) {
    const unsigned G = gridDim.x * gridDim.y * gridDim.z;
    unsigned sum, cnt, mine, sp = 0u;
    for (;;) {
        sum = 0u; cnt = 0u; mine = 0u;
#pragma unroll
        for (unsigned j = 0; j < 16; ++j) { const unsigned c = xb_ld(&bar[XB_XCNT(j)]); sum += c; cnt += (c > 0u) ? 1u : 0u; mine = (j == x) ? c : mine; }
        if (sum == G) break;
        __builtin_amdgcn_s_sleep(1);
        if ((++sp & 255u) == 0u) { if (xb_ld(&bar[XB_TMO])) break; if (sp > XB_SPIN_CAP) { atomicAdd(&bar[XB_TMO], 1u); break; } }
    }
    nloc = mine > 0u ? mine : 1u; nx = cnt > 0u ? cnt : 1u;
}

__device__ __forceinline__ void xcd_barrier(const XcdBarrier& b) {
    asm volatile("s_waitcnt vmcnt(0)" ::: "memory");
    __syncthreads();
    if (threadIdx.x == 0) {
        unsigned* bar = b.bar;
        __builtin_amdgcn_s_waitcnt(0);
        unsigned nloc = b.st[0], nx = b.st[1];
        if (nloc == 0u) { xcd_barrier_complete(bar, b.x, nloc, nx); b.st[0] = nloc; b.st[1] = nx; }
        const unsigned old = xb_add(&bar[XB_XSUB(b.x)], 1u);
        const unsigned gen = old / nloc;
        if (old + 1u == (gen + 1u) * nloc) {
            __builtin_amdgcn_fence(__ATOMIC_RELEASE, "agent");
            asm volatile("s_waitcnt vmcnt(0)" ::: "memory");
            const unsigned og = xb_add(&bar[XB_TOP], 1u);
            const unsigned tg = og / nx;
            if (og + 1u == (tg + 1u) * nx) xb_add(&bar[XB_TOPGEN], 1u);
            else XB_SPIN(xb_ld(&bar[XB_TOPGEN]) == tg, bar);
            __builtin_amdgcn_fence(__ATOMIC_ACQUIRE, "agent");
            xb_add(&bar[XB_XGEN(b.x)], 1u);
            asm volatile("s_waitcnt vmcnt(0)" ::: "memory");
        } else {
            XB_SPIN(xb_ld(&bar[XB_XGEN(b.x)]) == gen, bar);
            __builtin_amdgcn_fence(__ATOMIC_ACQUIRE, "agent");
            asm volatile("s_waitcnt vmcnt(0)" ::: "memory");
        }
    }
    __syncthreads();
}

#ifndef MK_SKIP
#define MK_SKIP 0
#endif
__global__ void __launch_bounds__(NTHR, 2) mk_fwd(Params p) {
    extern __shared__ __attribute__((aligned(16))) unsigned char lds_raw[];
    LAS unsigned char* lds = (LAS unsigned char*)lds_raw;
    cg::grid_group grid = cg::this_grid();
    const int tid = threadIdx.x, lane = tid & 63, wave = __builtin_amdgcn_readfirstlane(tid >> 6);
    const int G = gridDim.x, gw = blockIdx.x * NWAVES + wave, NGW = G * NWAVES;
    unsigned char* ws = p.ws;
    float* MOD = (float*)(ws + WS_MOD); bf16_t* HB = (bf16_t*)(ws + WS_HB); float* Y = p.out + O_Y;
    const int lo = p.ph_lo, hi = p.ph_hi;
    if (tid < 64) ((LAS unsigned*)(lds + LDS_CTL_OFF))[tid] = 0u;
    __syncthreads();
    XcdBarrier bar = xcd_barrier_post((unsigned*)ws, (volatile LAS unsigned*)(lds + LDS_CTL_OFF));
    if (lo < 0) grid.sync();
#define IN(k) (lo <= (k) && (k) < hi)
#define SEAM(k) do { if (IN(k) && IN((k) + 1)) xcd_barrier(bar); } while (0)

    if (IN(0) && !(MK_SKIP & (1 << 0))) phase_prep(p, lds, tid, wave, lane);
    SEAM(0);
    if (IN(1) && !(MK_SKIP & (1 << 1))) {
        for (int m = gw; m < M; m += NGW) { const int bi = batch_of_row(m); const float* xr = m < MP ? p.in[0] + (size_t)m * D : p.in[1] + (size_t)(m - MP) * D; const float* md = MOD + (size_t)bi * NMOD;
            f32x4 v[4];
#pragma unroll
            for (int j = 0; j < 4; ++j) v[j] = ((const f32x4*)xr)[lane + 64 * j];
            norm_mod_vals(v, p.in[8], md + 1024, md, HB + (size_t)m * D, lane); }
    }
    SEAM(1);
    if (IN(2) && !(MK_SKIP & (1 << 2))) {
        pg8::Gemm g{HB, (const bf16_t*)(ws + WS_WIN), M, NIN, D, D}; pg8::StaticOrder S; S.init(M, NIN, G, (int)blockIdx.x);
        EpiIn E{(bf16_t*)(ws + WS_Q), (bf16_t*)(ws + WS_K), (bf16_t*)(ws + WS_V), (bf16_t*)(ws + WS_R), (bf16_t*)(ws + WS_BG), (bf16_t*)(ws + WS_U), (float*)(ws + WS_GZ)};
        pg8::gemm_phase<EpiIn, pg8::StaticOrder, true, true>(lds, g, S, E);
    }
    SEAM(2);
    if (IN(3) && !(MK_SKIP & (1 << 3))) {
        LAS float* L = (LAS float*)(lds + wave * 16384);
        constexpr int N_DEC = 1024, N_VT = 2048, N_SMP = 512;
        for (int it = gw; it < N_DEC + N_VT + N_SMP + M; it += NGW) {
            int r = it;
            if (r < N_DEC) { gla_decay_item(p, r, lane); continue; } r -= N_DEC;
            if (r < N_VT) { gla_vt_item(p, r, lane); continue; } r -= N_VT;
            if (r < N_SMP) { gla_sample_item(p, r, L, lane); continue; } r -= N_SMP;
            conv_row(p, r, lane);
        }
    }
    SEAM(3);
    if (IN(4) && !(MK_SKIP & (1 << 4))) { for (int it = gw; it < 2048; it += NGW) gla_sloc_item(p, it, lane); }
    SEAM(4);
    if (IN(5) && !(MK_SKIP & (1 << 5))) gla_scan(p, tid);
    SEAM(5);
    if (IN(6) && !(MK_SKIP & (1 << 6))) { for (int it = gw; it < 2048; it += NGW) gla_out_item(p, it, lane); }
    SEAM(6);
    if (IN(7) && !(MK_SKIP & (1 << 7))) {
        { pg8::Gemm g{HB, (const bf16_t*)(ws + WS_WOUT), MP, D, D, D}; pg8::StaticOrder S; S.init(MP, D, G, (int)blockIdx.x);
          EpiRes<true> E{p.in[0], p.in[1], Y, MOD + 2048};
          pg8::gemm_phase<EpiRes<true>, pg8::StaticOrder, true, true>(lds, g, S, E); }
        { pg8::Gemm g{HB, (const bf16_t*)(ws + WS_WOUT), M, D, 256, D}; pg8::SplitOrder S; S.init(MP / 256, MS / 256, D / 256, 4, 256, G, (int)blockIdx.x);
          EpiSlab E{(float*)(ws + WS_SLAB), 256};
          pg8::gemm_phase<EpiSlab, pg8::SplitOrder, true, true>(lds, g, S, E); }
    }
    SEAM(7);
    if (IN(8) && !(MK_SKIP & (1 << 8))) {
        for (int m = gw; m < M; m += NGW) { const int bi = batch_of_row(m); const float* md = MOD + (size_t)bi * NMOD;
            f32x4 v[4];
            if (m < MP) {
#pragma unroll
                for (int j = 0; j < 4; ++j) v[j] = ((const f32x4*)(Y + (size_t)m * D))[lane + 64 * j];
            } else { slab_row<4>(p.in[1] + (size_t)(m - MP) * D, md + 2048, (const float*)(ws + WS_SLAB), m - MP, lane, v);
#pragma unroll
                for (int j = 0; j < 4; ++j) ((f32x4*)(Y + (size_t)m * D))[lane + 64 * j] = v[j]; }
            norm_mod_vals(v, p.in[15], md + 4096, md + 3072, HB + (size_t)m * D, lane); }
    }
    SEAM(8);
    if (IN(9) && !(MK_SKIP & (1 << 9))) {
        pg8::Gemm g{HB, (const bf16_t*)(ws + WS_WUP), M, FF, D, D}; pg8::StaticOrder S; S.init(M, FF, G, (int)blockIdx.x);
        EpiUp E{(bf16_t*)(ws + WS_ACT)};
        pg8::gemm_phase<EpiUp, pg8::StaticOrder, true, true>(lds, g, S, E);
    }
    SEAM(9);
    if (IN(10) && !(MK_SKIP & (1 << 10))) {
        { pg8::Gemm g{(const bf16_t*)(ws + WS_ACT), (const bf16_t*)(ws + WS_WDN), MP, D, FF, FF}; pg8::StaticOrder S; S.init(MP, D, G, (int)blockIdx.x);
          EpiRes<false> E{nullptr, nullptr, Y, MOD + 5120};
          pg8::gemm_phase<EpiRes<false>, pg8::StaticOrder, true, true>(lds, g, S, E); }
        { pg8::Gemm g{(const bf16_t*)(ws + WS_ACT), (const bf16_t*)(ws + WS_WDN), M, D, 512, FF}; pg8::SplitOrder S; S.init(MP / 256, MS / 256, D / 256, 8, 512, G, (int)blockIdx.x);
          EpiSlab E{(float*)(ws + WS_SLAB), 512};
          pg8::gemm_phase<EpiSlab, pg8::SplitOrder, true, true>(lds, g, S, E); }
    }
    SEAM(10);
    if (IN(11) && !(MK_SKIP & (1 << 11))) {
        const float* fg = p.in[18];
        for (int m = gw; m < M; m += NGW) { f32x4* xr = (f32x4*)(Y + (size_t)m * D) + lane; f32x4 v[4]; float s = 0.f;
            if (m < MP) {
#pragma unroll
                for (int j = 0; j < 4; ++j) v[j] = xr[64 * j];
            } else slab_row<8>(Y + (size_t)m * D, MOD + (size_t)batch_of_row(m) * NMOD + 5120, (const float*)(ws + WS_SLAB), m - MP, lane, v);
#pragma unroll
            for (int j = 0; j < 4; ++j) s += (v[j][0] * v[j][0] + v[j][1] * v[j][1]) + (v[j][2] * v[j][2] + v[j][3] * v[j][3]);
            const float rstd = 1.0f / sqrtf(wave_sum(s) * (1.f / D) + EPS);
#pragma unroll
            for (int j = 0; j < 4; ++j) xr[64 * j] = v[j] * rstd * ((const f32x4*)fg)[lane + 64 * j]; }
    }
#undef IN
#undef SEAM
}

#ifndef MK_SPLIT

#define MK_SPLIT 0
#endif
constexpr int N_PHASES = 12;
extern "C" void kernel_launch(void* const* d_in, const int* in_sizes, int n_in, void* d_out, int out_size, void* d_ws, size_t ws_size, hipStream_t stream) {
    static int grid = 0;
    if (grid == 0) {
        int dev = 0, cus = 0, per_cu = 0;
        if (hipGetDevice(&dev) != hipSuccess || hipDeviceGetAttribute(&cus, hipDeviceAttributeMultiprocessorCount, dev) != hipSuccess) { fprintf(stderr, "kernel_launch: device query failed\n"); grid = -1; return; }
        if (hipFuncSetAttribute((const void*)mk_fwd, hipFuncAttributeMaxDynamicSharedMemorySize, LDS_BYTES) != hipSuccess) { fprintf(stderr, "kernel_launch: hipFuncSetAttribute failed\n"); grid = -1; return; }
        if (hipOccupancyMaxActiveBlocksPerMultiprocessor(&per_cu, (const void*)mk_fwd, NTHR, LDS_BYTES) != hipSuccess || per_cu < 1) { fprintf(stderr, "kernel_launch: occupancy query says %d\n", per_cu); per_cu = 1; }
        (void)hipGetLastError();
        grid = cus;
        if (n_in != 19 || ws_size < WS_END || (size_t)ws_size < WS_ACT + (size_t)M * FF * 2) { fprintf(stderr, "kernel_launch: unexpected n_in %d / ws %zu\n", n_in, ws_size); grid = -1; return; }
    }
    if (grid < 0) return;
    if (hipMemsetAsync(d_ws, 0, 16384, stream) != hipSuccess) { fprintf(stderr, "kernel_launch: memset failed\n"); return; }
    Params p{};
    for (int i = 0; i < 19; ++i) p.in[i] = (const float*)d_in[i];
    p.out = (float*)d_out; p.ws = (unsigned char*)d_ws;
#if MK_SPLIT
    for (int ph = 0; ph < N_PHASES; ++ph) { p.ph_lo = ph; p.ph_hi = ph + 1; hipLaunchKernelGGL(mk_fwd, dim3(grid), dim3(NTHR), LDS_BYTES, stream, p); }
#else
    p.ph_lo = 0; p.ph_hi = N_PHASES;
    void* args[] = {&p};
    hipError_t e = hipLaunchCooperativeKernel((const void*)mk_fwd, dim3(grid), dim3(NTHR), args, LDS_BYTES, stream);
    if (e != hipSuccess) fprintf(stderr, "kernel_launch: cooperative launch failed: %s (grid %d)\n", hipGetErrorString(e), grid);
#endif
}
```

```cpp
#include <hip/hip_runtime.h>
#include <hip/hip_cooperative_groups.h>
#include <cstdio>
#include <cstdint>
namespace cg = cooperative_groups;
namespace pg8 {
#define PG8_LAS __attribute__((address_space(3)))
typedef unsigned short bf16_t;
typedef short bf16x8 __attribute__((ext_vector_type(8)));
typedef float f32x4 __attribute__((ext_vector_type(4)));
typedef unsigned u32x4 __attribute__((ext_vector_type(4)));
constexpr int BM = 256, BK = 64, HALF = 128, HTB = HALF * BK * 2  , STAGE_BYTES = 8 * HTB, NXCD = 8, WGM = 8;

__host__ __device__ __forceinline__ int lds_byte(int r, int c) { const int st = (r >> 4) * 2 + (c >> 5), rr = r & 15, cc = c & 31, ob = rr * 64 + cc * 2; return st * 1024 + (ob ^ (((ob >> 9) & 1) << 5)); }
__host__ __device__ __forceinline__ void stage_rc(int b, int& R, int& C) { const int st = b / 1024, sb = b % 1024, swz = sb ^ (((sb >> 9) & 1) << 5); R = (st >> 1) * 16 + swz / 64; C = (st & 1) * 32 + (swz % 64) / 2; }
__host__ __device__ __forceinline__ int perm32(int rho) { const int n = rho >> 4, i = rho & 15; return 8 * (i >> 2) + 4 * n + (i & 3); }

struct Unit { int pm, pn, kof; };
struct Gemm { const bf16_t* A; const bf16_t* Bt; int M, N, K, ld; };

struct StaticOrder {
    int nM, nN, nwg, G, c;
    __host__ __device__ void init(int M, int N, int G_, int c_) { nM = M / BM; nN = N / BM; nwg = nM * nN; G = G_; c = c_; }
    __host__ __device__ bool next(int i, Unit& u) const {
        const long L = (long)i * G + c; if (L >= nwg) return false;
        int wgid = (int)L; { const int q = nwg / NXCD, r = nwg % NXCD, xcd = wgid % NXCD, off = wgid / NXCD; wgid = (xcd < r ? xcd * (q + 1) : r * (q + 1) + (xcd - r) * q) + off; }
        const int nig = WGM * nN, gid = wgid / nig, fm = gid * WGM, gsz = (nM - fm) < WGM ? (nM - fm) : WGM;
        u.pm = fm + ((wgid % nig) % gsz); u.pn = (wgid % nig) / gsz; u.kof = 0; return true;
    }
    __device__ __forceinline__ void a_ready(const Unit&) const {}
    __device__ __forceinline__ void done(const Unit&) const {}
};

struct SplitOrder {
    int pm0, nN, nsplit, kslice, nitems, G, c;
    __host__ __device__ void init(int pm0_, int npm, int nN_, int nsplit_, int kslice_, int G_, int c_) { pm0 = pm0_; nN = nN_; nsplit = nsplit_; kslice = kslice_; nitems = npm * nN_ * nsplit_; G = G_; c = c_; }
    __host__ __device__ bool next(int i, Unit& u) const { const long L = (long)i * G + c; if (L >= nitems) return false; const int l = (int)L, ks = l % nsplit, t = l / nsplit; u.pn = t % nN; u.pm = pm0 + t / nN; u.kof = ks * kslice; return true; }
    __device__ __forceinline__ void a_ready(const Unit&) const {}
    __device__ __forceinline__ void done(const Unit&) const {}
};

__device__ __forceinline__ unsigned cvt_pk_bf16(float lo, float hi) { unsigned r; asm volatile("v_cvt_pk_bf16_f32 %0, %1, %2" : "=v"(r) : "v"(lo), "v"(hi)); return r; }
template <class Epi, class Sched, bool ALIGN_EPI = false, bool SP2 = false>
__device__ __forceinline__ void gemm_phase(PG8_LAS unsigned char* lds, const Gemm g, const Sched& S, const Epi& E) {
    const int tid = threadIdx.x, wid = __builtin_amdgcn_readfirstlane(tid >> 6), lane = tid & 63, wr = wid >> 2, wc = wid & 3, fr = lane & 15, fq = lane >> 4;
    const int K = g.ld, nt = g.K / BK;
    unsigned voffA[2], voffB[2];
#pragma unroll
    for (int i = 0; i < 2; ++i) { int R, C; stage_rc(tid * 16 + i * 8192, R, C); const int Rb = Epi::PERM ? ((R & ~31) + perm32(R & 31)) : R;
        voffA[i] = (unsigned)(R * K + C) * 2u; voffB[i] = (unsigned)(Rb * K + C) * 2u; }
    const size_t kstep = (size_t)(BK * 2);
    const size_t hstep = (size_t)HALF * K * 2;
    const size_t tstep = 2 * hstep;
    const unsigned ldsw = (unsigned)wid * 1024u;
    const int aoff = lds_byte(wr * 64 + fr, fq * 8), boff = lds_byte(wc * 32 + fr, fq * 8);
#define PG8_SA(b, h) (((b) * 2 + (h)) * HTB)
#define PG8_SB(b, h) ((4 + (b) * 2 + (h)) * HTB)
#define PG8_STAGE(bufoff, gbase, voff) do { _Pragma("unroll") for (int _i = 0; _i < 2; ++_i) \
        __builtin_amdgcn_global_load_lds((const unsigned*)((const char*)(gbase) + (voff)[_i]), (PG8_LAS unsigned*)(lds + (bufoff) + ldsw + _i * 8192), 16, 0, 0); } while (0)
#define PG8_LDA(dst, b, h) do { _Pragma("unroll") for (int m = 0; m < 4; ++m) _Pragma("unroll") for (int k = 0; k < 2; ++k) dst[m][k] = *(const PG8_LAS bf16x8*)(lds + PG8_SA(b, h) + aoff + m * 2048 + k * 1024); } while (0)
#define PG8_LDB(dst, b, h) do { _Pragma("unroll") for (int n = 0; n < 2; ++n) _Pragma("unroll") for (int k = 0; k < 2; ++k) dst[n][k] = *(const PG8_LAS bf16x8*)(lds + PG8_SB(b, h) + boff + n * 2048 + k * 1024); } while (0)
#define PG8_MMA(ai, bj, At, Bt) do { __builtin_amdgcn_s_setprio(1); _Pragma("unroll") for (int m = 0; m < 4; ++m) _Pragma("unroll") for (int n = 0; n < 2; ++n) _Pragma("unroll") for (int k = 0; k < 2; ++k) \
        acc[ai][bj][m][n] = __builtin_amdgcn_mfma_f32_16x16x32_bf16(Bt[n][k], At[m][k], acc[ai][bj][m][n], 0, 0, 0); __builtin_amdgcn_s_setprio(0); } while (0)
#define PG8_WAIT_V(n) asm volatile("s_waitcnt vmcnt(" #n ")" ::: "memory")
#define PG8_WAIT_L(n) asm volatile("s_waitcnt lgkmcnt(" #n ")" ::: "memory")
#define PG8_BAR __builtin_amdgcn_s_barrier()
#define PG8_SCHED __builtin_amdgcn_sched_barrier(0)
    Unit cur, nxt; int ui = 0;
    if (!S.next(0, cur)) return;
    f32x4 acc[2][2][4][2];
#pragma unroll
    for (int a = 0; a < 2; ++a)
#pragma unroll
        for (int b = 0; b < 2; ++b)
#pragma unroll
            for (int m = 0; m < 4; ++m)
#pragma unroll
                for (int n = 0; n < 2; ++n) acc[a][b][m][n] = (f32x4){0.f, 0.f, 0.f, 0.f};
    bf16x8 At[4][2], B0[2][2], B1[2][2];
    const char* cA = (const char*)g.A + (size_t)cur.pm * tstep + (size_t)cur.kof * 2; const char* cB = (const char*)g.Bt + (size_t)cur.pn * tstep + (size_t)cur.kof * 2;
    S.a_ready(cur);
    if constexpr (SP2) {
        PG8_STAGE(PG8_SB(0, 0), cB, voffB); PG8_STAGE(PG8_SB(0, 1), cB + hstep, voffB); PG8_STAGE(PG8_SA(0, 0), cA, voffA); PG8_STAGE(PG8_SA(0, 1), cA + hstep, voffA);
        if (wr == 1) PG8_BAR;
        PG8_WAIT_V(2); PG8_BAR;
        PG8_STAGE(PG8_SB(1, 0), cB + kstep, voffB); PG8_STAGE(PG8_SA(1, 0), cA + kstep, voffA); PG8_STAGE(PG8_SB(1, 1), cB + hstep + kstep, voffB);
        PG8_WAIT_V(6); PG8_BAR;
    } else {
        PG8_STAGE(PG8_SB(0, 0), cB, voffB); PG8_STAGE(PG8_SA(0, 0), cA, voffA); PG8_STAGE(PG8_SB(0, 1), cB + hstep, voffB); PG8_STAGE(PG8_SA(0, 1), cA + hstep, voffA);
        if (wr == 1) PG8_BAR;
        PG8_WAIT_V(4); PG8_BAR;
        PG8_STAGE(PG8_SB(1, 0), cB + kstep, voffB); PG8_STAGE(PG8_SA(1, 0), cA + kstep, voffA); PG8_STAGE(PG8_SB(1, 1), cB + hstep + kstep, voffB);
        PG8_WAIT_V(6); PG8_BAR;
    }
    for (;;) {
        const bool has_next = S.next(ui + 1, nxt);
        const char* nA = has_next ? (const char*)g.A + (size_t)nxt.pm * tstep + (size_t)nxt.kof * 2 : cA; const char* nB = has_next ? (const char*)g.Bt + (size_t)nxt.pn * tstep + (size_t)nxt.kof * 2 : cB;
        for (int t = 0; t < nt; t += 2) {
            const bool last = (t == nt - 2);
            const char* a1 = cA + (size_t)(t + 1) * kstep;
            const char* a2 = last ? nA : cA + (size_t)(t + 2) * kstep; const char* b2 = last ? nB : cB + (size_t)(t + 2) * kstep;
            const char* a3 = a2 + kstep; const char* b3 = b2 + kstep;
            if (last && has_next) S.a_ready(nxt);
            if constexpr (SP2) {
            PG8_LDB(B0, 0, 0); PG8_LDB(B1, 0, 1); PG8_SCHED; PG8_LDA(At, 0, 0); PG8_STAGE(PG8_SA(1, 1), a1 + hstep, voffA);
            PG8_WAIT_V(8); PG8_WAIT_L(0); PG8_BAR; PG8_MMA(0, 0, At, B0); PG8_MMA(0, 1, At, B1); PG8_BAR; PG8_SCHED;
            PG8_LDA(At, 0, 1); PG8_STAGE(PG8_SB(0, 0), b2, voffB); PG8_STAGE(PG8_SB(0, 1), b2 + hstep, voffB); PG8_STAGE(PG8_SA(0, 0), a2, voffA);
            PG8_WAIT_V(8); PG8_WAIT_L(0); PG8_BAR; PG8_MMA(1, 0, At, B0); PG8_MMA(1, 1, At, B1); PG8_BAR; PG8_SCHED;
            PG8_LDB(B0, 1, 0); PG8_LDB(B1, 1, 1); PG8_SCHED; PG8_LDA(At, 1, 0); PG8_STAGE(PG8_SA(0, 1), a2 + hstep, voffA);
            PG8_WAIT_V(8); PG8_WAIT_L(0); PG8_BAR; PG8_MMA(0, 0, At, B0); PG8_MMA(0, 1, At, B1); PG8_BAR; PG8_SCHED;
            PG8_LDA(At, 1, 1); PG8_STAGE(PG8_SB(1, 0), b3, voffB); PG8_STAGE(PG8_SB(1, 1), b3 + hstep, voffB); PG8_STAGE(PG8_SA(1, 0), a3, voffA);
            PG8_WAIT_V(8); PG8_WAIT_L(0); PG8_BAR; PG8_MMA(1, 0, At, B0); PG8_MMA(1, 1, At, B1); PG8_BAR; PG8_SCHED;
            } else {
            PG8_LDB(B0, 0, 0); PG8_SCHED; PG8_LDA(At, 0, 0); PG8_STAGE(PG8_SA(1, 1), a1 + hstep, voffA);
            PG8_WAIT_L(8); PG8_BAR; PG8_WAIT_L(0); PG8_MMA(0, 0, At, B0); PG8_BAR; PG8_SCHED;
            PG8_LDB(B1, 0, 1); PG8_STAGE(PG8_SB(0, 0), b2, voffB);
            PG8_BAR; PG8_WAIT_L(0); PG8_MMA(0, 1, At, B1); PG8_BAR;
            PG8_LDA(At, 0, 1); PG8_STAGE(PG8_SA(0, 0), a2, voffA);
            PG8_BAR; PG8_WAIT_L(0); PG8_MMA(1, 0, At, B0); PG8_BAR; PG8_SCHED;
            PG8_STAGE(PG8_SB(0, 1), b2 + hstep, voffB);
            PG8_WAIT_V(6); PG8_BAR; PG8_MMA(1, 1, At, B1); PG8_BAR;
            PG8_LDB(B0, 1, 0); PG8_SCHED; PG8_LDA(At, 1, 0); PG8_STAGE(PG8_SA(0, 1), a2 + hstep, voffA);
            PG8_WAIT_L(8); PG8_BAR; PG8_WAIT_L(0); PG8_MMA(0, 0, At, B0); PG8_BAR; PG8_SCHED;
            PG8_LDB(B1, 1, 1); PG8_STAGE(PG8_SB(1, 0), b3, voffB);
            PG8_BAR; PG8_WAIT_L(0); PG8_MMA(0, 1, At, B1); PG8_BAR;
            PG8_LDA(At, 1, 1); PG8_STAGE(PG8_SA(1, 0), a3, voffA);
            PG8_BAR; PG8_WAIT_L(0); PG8_MMA(1, 0, At, B0); PG8_BAR; PG8_SCHED;
            PG8_STAGE(PG8_SB(1, 1), b3 + hstep, voffB);
            PG8_WAIT_V(6); PG8_BAR; PG8_MMA(1, 1, At, B1); PG8_BAR;
            }
        }
        if constexpr (ALIGN_EPI) { if (wr == 0) PG8_BAR; }
        if constexpr (!Epi::AFTER_DRAIN) { E(acc, cur, wr, wc, fr, fq); S.done(cur); }
        if (!has_next) break;
#pragma unroll
        for (int a = 0; a < 2; ++a)
#pragma unroll
            for (int b = 0; b < 2; ++b)
#pragma unroll
                for (int m = 0; m < 4; ++m)
#pragma unroll
                    for (int n = 0; n < 2; ++n) acc[a][b][m][n] = (f32x4){0.f, 0.f, 0.f, 0.f};
        cur = nxt; cA = nA; cB = nB; ++ui;
        if constexpr (ALIGN_EPI) { if (wr == 1) PG8_BAR; }
    }
    PG8_WAIT_V(0);
    if constexpr (!ALIGN_EPI) { if (wr == 0) PG8_BAR; }
    PG8_BAR;
    if constexpr (Epi::AFTER_DRAIN) { E.fused(acc, cur, wr, wc, fr, fq, lds, wid, lane); S.done(cur); }
#undef PG8_SA
#undef PG8_SB
#undef PG8_STAGE
#undef PG8_LDA
#undef PG8_LDB
#undef PG8_MMA
#undef PG8_WAIT_V
#undef PG8_WAIT_L
#undef PG8_BAR
#undef PG8_SCHED
}
}

#define LAS __attribute__((address_space(3)))
typedef unsigned short bf16_t;
typedef short bf16x8 __attribute__((ext_vector_type(8)));
typedef short bf16x4 __attribute__((ext_vector_type(4)));
typedef float f32x4 __attribute__((ext_vector_type(4)));
typedef unsigned u32x4 __attribute__((ext_vector_type(4)));
typedef unsigned u32x2 __attribute__((ext_vector_type(2)));

constexpr int NTHR = 512, NWAVES = 8;
constexpr int D = 1024, MP = 16384, MS = 1024, M = MP + MS, NBATCH = 136, NIN = 3328, FF = 4096, NMOD = 6144;
constexpr int SEQ = 2048, DSEQ = 8;
constexpr float EPS = 1e-6f;
constexpr size_t HM = 524288;
constexpr size_t WS_MOD = 2 * HM, WS_WIN = 10 * HM, WS_WOUT = 24 * HM, WS_WUP = 28 * HM, WS_WDN = 44 * HM, WS_HB = 60 * HM;
constexpr size_t WS_ACT = 128 * HM;
constexpr size_t WS_Q = 128 * HM, WS_K = 145 * HM, WS_V = 162 * HM, WS_R = 196 * HM, WS_BG = 230 * HM, WS_U = 264 * HM, WS_GZ = 298 * HM;
constexpr size_t WS_KOUT = 302 * HM, WS_VT = 318 * HM, WS_SLOC = 350 * HM, WS_DEC = 414 * HM, WS_SLAB = 416 * HM, WS_END = 480 * HM;
static_assert(WS_ACT + (size_t)M * FF * 2 <= 512 * HM && WS_END <= 512 * HM, "workspace map");
constexpr size_t O_Y = 0, O_NGP = (size_t)M * D, O_NCP = O_NGP + 8 * 4 * 64 * 128, O_NGS = O_NCP + 8 * 2 * 512, O_NCS = O_NGS + (size_t)128 * 4 * 64 * 128;
constexpr int LDS_BYTES = 135168, LDS_CTL_OFF = 131072;

struct Params {
    const float* in[19];
    float* out; unsigned char* ws;
    int ph_lo, ph_hi;
};

__device__ __forceinline__ float bf2f(unsigned short b) { return __uint_as_float(((unsigned)b) << 16); }
__device__ __forceinline__ unsigned pk_bf16(float lo, float hi) { return pg8::cvt_pk_bf16(lo, hi); }
__device__ __forceinline__ float wave_sum(float v) {
#pragma unroll
    for (int o = 1; o < 64; o <<= 1) v += __shfl_xor(v, o);
    return v;
}
__device__ __forceinline__ float silu_f(float x) { return x * __builtin_amdgcn_rcpf(1.0f + __expf(-x)); }
__device__ __forceinline__ float logsigmoid_f(float z) { return fminf(z, 0.f) - __logf(1.0f + __expf(-fabsf(z))); }
__device__ __forceinline__ int batch_of_row(int m) { return m < MP ? (m >> 11) : 8 + ((m - MP) >> 3); }
#define LDS_WAIT() asm volatile("s_waitcnt lgkmcnt(0)" ::: "memory")

struct EpiIn {
    static constexpr bool PERM = true, AFTER_DRAIN = false;
    bf16_t *Q, *K, *V, *R, *BG, *U; float* GZ;
    __device__ __forceinline__ void operator()(const f32x4 (&acc)[2][2][4][2], const pg8::Unit& u, int wr, int wc, int fr, int fq) const {
        const int row0 = u.pm * 256 + wr * 64 + fr, cl = wc * 32 + 8 * fq, pn = u.pn;
        if (pn < 8) {
            bf16_t* base; int ldc, colt; float sc = 1.f; bool act = false;
            if (pn == 0) { base = Q; ldc = 256; colt = 0; sc = 0.125f; }
            else if (pn == 1) { base = K; ldc = 256; colt = 0; }
            else if (pn < 4) { base = V; ldc = 512; colt = (pn - 2) * 256; }
            else if (pn < 6) { base = R; ldc = 512; colt = (pn - 4) * 256; act = true; }
            else { base = BG; ldc = 512; colt = (pn - 6) * 256; }
#pragma unroll
            for (int ai = 0; ai < 2; ++ai)
#pragma unroll
                for (int m = 0; m < 4; ++m) { bf16_t* rowp = base + (size_t)(row0 + ai * 128 + m * 16) * ldc + colt + cl;
#pragma unroll
                    for (int bj = 0; bj < 2; ++bj) { f32x4 v0 = acc[ai][bj][m][0] * sc, v1 = acc[ai][bj][m][1] * sc;
                        if (act) {
#pragma unroll
                            for (int j = 0; j < 4; ++j) { v0[j] = silu_f(v0[j]); v1[j] = silu_f(v1[j]); } }
                        u32x4 w; w.x = pk_bf16(v0[0], v0[1]); w.y = pk_bf16(v0[2], v0[3]); w.z = pk_bf16(v1[0], v1[1]); w.w = pk_bf16(v1[2], v1[3]);
                        *(u32x4*)(rowp + bj * 128) = w; } }
        } else if (pn < 12) {
            const int j0 = (pn - 8) * 128 + cl;
#pragma unroll
            for (int ai = 0; ai < 2; ++ai)
#pragma unroll
                for (int m = 0; m < 4; ++m) { bf16_t* rowp = U + (size_t)(row0 + ai * 128 + m * 16) * 512 + j0;
                    const f32x4 v0 = acc[ai][0][m][0] * acc[ai][1][m][0], v1 = acc[ai][0][m][1] * acc[ai][1][m][1];
                    u32x4 w; w.x = pk_bf16(v0[0], v0[1]); w.y = pk_bf16(v0[2], v0[3]); w.z = pk_bf16(v1[0], v1[1]); w.w = pk_bf16(v1[2], v1[3]);
                    *(u32x4*)rowp = w; }
        } else {
            if (wc == 0 && fq < 2) {
#pragma unroll
                for (int ai = 0; ai < 2; ++ai)
#pragma unroll
                    for (int m = 0; m < 4; ++m) { float* rowp = GZ + (size_t)(row0 + ai * 128 + m * 16) * 16 + 8 * fq;
                        *(f32x4*)rowp = acc[ai][0][m][0]; *(f32x4*)(rowp + 4) = acc[ai][0][m][1]; }
            }
        }
    }
};
struct EpiUp {
    static constexpr bool PERM = true, AFTER_DRAIN = false;
    bf16_t* O;
    __device__ __forceinline__ void operator()(const f32x4 (&acc)[2][2][4][2], const pg8::Unit& u, int wr, int wc, int fr, int fq) const {
        const int row0 = u.pm * 256 + wr * 64 + fr, col0 = u.pn * 256 + wc * 32 + 8 * fq;
#pragma unroll
        for (int ai = 0; ai < 2; ++ai)
#pragma unroll
            for (int m = 0; m < 4; ++m) { bf16_t* rowp = O + (size_t)(row0 + ai * 128 + m * 16) * FF + col0;
#pragma unroll
                for (int bj = 0; bj < 2; ++bj) { f32x4 v0 = acc[ai][bj][m][0], v1 = acc[ai][bj][m][1];
#pragma unroll
                    for (int j = 0; j < 4; ++j) { const float a = fmaxf(v0[j], 0.f), b = fmaxf(v1[j], 0.f); v0[j] = a * a; v1[j] = b * b; }
                    u32x4 w; w.x = pk_bf16(v0[0], v0[1]); w.y = pk_bf16(v0[2], v0[3]); w.z = pk_bf16(v1[0], v1[1]); w.w = pk_bf16(v1[2], v1[3]);
                    *(u32x4*)(rowp + bj * 128) = w; } }
    }
};
template <bool FROM_X> struct EpiRes {
    static constexpr bool PERM = false, AFTER_DRAIN = false;
    const float* xp; const float* xs; float* Y; const float* gate;
    __device__ __forceinline__ void operator()(const f32x4 (&acc)[2][2][4][2], const pg8::Unit& u, int wr, int wc, int fr, int fq) const {
        const int row0 = u.pm * 256 + wr * 64 + fr, col0 = u.pn * 256 + wc * 32 + 4 * fq;
#pragma unroll
        for (int ai = 0; ai < 2; ++ai)
#pragma unroll
            for (int m = 0; m < 4; ++m) { const int row = row0 + ai * 128 + m * 16; const int bi = batch_of_row(row);
                const float* gp = gate + (size_t)bi * NMOD + col0; float* yp = Y + (size_t)row * D + col0;
                const float* bp = FROM_X ? ((row < MP ? xp + (size_t)row * D : xs + (size_t)(row - MP) * D) + col0) : (const float*)yp;
#pragma unroll
                for (int bj = 0; bj < 2; ++bj)
#pragma unroll
                    for (int n = 0; n < 2; ++n) { const int o = bj * 128 + n * 16; const f32x4 g = *(const f32x4*)(gp + o), b = *(const f32x4*)(bp + o);
                        *(f32x4*)(yp + o) = b + g * acc[ai][bj][m][n]; }
                asm volatile("" ::: "memory"); }
    }
};

struct EpiSlab {
    static constexpr bool PERM = false, AFTER_DRAIN = false;
    float* S; int kslice;
    __device__ __forceinline__ void operator()(const f32x4 (&acc)[2][2][4][2], const pg8::Unit& u, int wr, int wc, int fr, int fq) const {
        const int row0 = u.pm * 256 - MP + wr * 64 + fr, col0 = u.pn * 256 + wc * 32 + 4 * fq; float* base = S + (size_t)(u.kof / kslice) * MS * D;
#pragma unroll
        for (int ai = 0; ai < 2; ++ai)
#pragma unroll
            for (int m = 0; m < 4; ++m) { float* yp = base + (size_t)(row0 + ai * 128 + m * 16) * D + col0;
#pragma unroll
                for (int bj = 0; bj < 2; ++bj)
#pragma unroll
                    for (int n = 0; n < 2; ++n) *(f32x4*)(yp + bj * 128 + n * 16) = acc[ai][bj][m][n]; }
    }
};

__device__ __forceinline__ void tr_item(const float* W, int ldn, int Kdim, int k0, int n0src, int nvalid, bf16_t* WT, int n0dst, LAS float* scr, int lane) {
    const int nn = lane & 31;
#pragma unroll 8
    for (int i = 0; i < 32; ++i) { const int kk = 2 * i + (lane >> 5); scr[kk * 33 + nn] = (nn < nvalid) ? W[(size_t)(k0 + kk) * ldn + n0src + nn] : 0.f; }
    LDS_WAIT();
    const int c = lane & 7;
#pragma unroll
    for (int j = 0; j < 4; ++j) { const int n = (lane >> 3) + 8 * j; const LAS float* s = scr + (8 * c) * 33 + n;
        u32x4 o; o.x = pk_bf16(s[0 * 33], s[1 * 33]); o.y = pk_bf16(s[2 * 33], s[3 * 33]); o.z = pk_bf16(s[4 * 33], s[5 * 33]); o.w = pk_bf16(s[6 * 33], s[7 * 33]);
        *(u32x4*)(WT + (size_t)(n0dst + n) * Kdim + k0 + 8 * c) = o; }
    LDS_WAIT();
}
__device__ __forceinline__ void win_map(int vc0, int& src, int& nvalid) {
    nvalid = 32;
    if (vc0 < 1024) src = vc0;
    else if (vc0 < 2048) src = vc0 + 16;
    else if (vc0 < 3072) { const int j = (vc0 - 2048) >> 8, w = (vc0 - 2048) & 255; src = (w < 128) ? (2064 + 128 * j + w) : (2576 + 128 * j + (w - 128)); }
    else { src = 1024 + (vc0 - 3072); nvalid = (vc0 == 3072) ? 16 : 0; if (nvalid == 0) src = 0; }
}
__device__ __forceinline__ void phase_prep(const Params& p, LAS unsigned char* lds, int tid, int wave, int lane) {
    const int G = gridDim.x;
    unsigned char* ws = p.ws;
    {
        const float* w_ada = p.in[6]; const float* b_ada = p.in[7]; float* MOD = (float*)(ws + WS_MOD);
        const int fr = lane & 15, fq = lane >> 4, ct = wave & 1, kq = wave >> 1;
        for (int it = blockIdx.x; it < 192; it += G) {
            const int n0 = it * 32;
            f32x4 acc[9];
#pragma unroll
            for (int rt = 0; rt < 9; ++rt) acc[rt] = (f32x4){0.f, 0.f, 0.f, 0.f};
#pragma unroll 1
            for (int kc = 0; kc < 4; ++kc) {
                float wreg[2][8];
#pragma unroll
                for (int s = 0; s < 2; ++s) { const float* wp = w_ada + (size_t)(256 * kc + 32 * (2 * kq + s) + 8 * fq) * NMOD + n0 + 16 * ct + fr;
#pragma unroll
                    for (int j = 0; j < 8; ++j) wreg[s][j] = wp[(size_t)j * NMOD]; }
                __syncthreads();
                for (int idx = tid; idx < 144 * 64; idx += NTHR) { const int r = idx >> 6, k4 = (idx & 63) * 4; f32x4 cv = (f32x4){0.f, 0.f, 0.f, 0.f};
                    if (r < NBATCH) cv = *(const f32x4*)((r < 8 ? p.in[4] + (size_t)r * D : p.in[5] + (size_t)(r - 8) * D) + 256 * kc + k4);
                    u32x2 w; w.x = pk_bf16(silu_f(cv[0]), silu_f(cv[1])); w.y = pk_bf16(silu_f(cv[2]), silu_f(cv[3]));
                    *(LAS u32x2*)(lds + r * 528 + k4 * 2) = w; }
                __syncthreads();
#pragma unroll
                for (int s = 0; s < 2; ++s) {
                    float w8[8];
#pragma unroll
                    for (int j = 0; j < 8; ++j) w8[j] = wreg[s][j];
                    u32x4 bw; bw.x = pk_bf16(w8[0], w8[1]); bw.y = pk_bf16(w8[2], w8[3]); bw.z = pk_bf16(w8[4], w8[5]); bw.w = pk_bf16(w8[6], w8[7]);
                    const bf16x8 Bf = __builtin_bit_cast(bf16x8, bw);
#pragma unroll
                    for (int rt = 0; rt < 9; ++rt) { const bf16x8 Af = *(const LAS bf16x8*)(lds + (16 * rt + fr) * 528 + (32 * (2 * kq + s) + 8 * fq) * 2);
                        acc[rt] = __builtin_amdgcn_mfma_f32_16x16x32_bf16(Af, Bf, acc[rt], 0, 0, 0); }
                }
            }
            __syncthreads();
            LAS float* RED = (LAS float*)lds;
#pragma unroll
            for (int rt = 0; rt < 9; ++rt)
#pragma unroll
                for (int i = 0; i < 4; ++i) RED[((wave * 9 + rt) * 4 + i) * 64 + lane] = acc[rt][i];
            __syncthreads();
#pragma unroll
            for (int e = 0; e < 3; ++e) { const int rt = kq + 4 * e;
                if (rt < 9) {
#pragma unroll
                    for (int i = 0; i < 4; ++i) { const int row = 16 * rt + 4 * fq + i; float s = 0.f;
#pragma unroll
                        for (int q = 0; q < 4; ++q) s += RED[(((q * 2 + ct) * 9 + rt) * 4 + i) * 64 + lane];
                        if (row < NBATCH) MOD[(size_t)row * NMOD + n0 + 16 * ct + fr] = s + b_ada[n0 + 16 * ct + fr]; } } }
        }
        __syncthreads();
    }
    {
        LAS float* scr = (LAS float*)(lds + wave * 16384);
        const int gw = blockIdx.x * NWAVES + wave, NGW = G * NWAVES;
        constexpr int I_IN = 16 * (NIN / 32), I_OUT = 16 * 32, I_UP = 16 * 128, I_DN = 64 * 32;
        for (int it = gw; it < I_IN + I_OUT + I_UP + I_DN; it += NGW) {
            int r = it;
            if (r < I_IN) { const int nb = r % (NIN / 32), kb = r / (NIN / 32); int src, nv; win_map(nb * 32, src, nv);
                tr_item(p.in[9], 3088, D, kb * 64, src, nv, (bf16_t*)(ws + WS_WIN), nb * 32, scr, lane); continue; } r -= I_IN;
            if (r < I_OUT) { const int nb = r % 32, kb = r / 32; tr_item(p.in[14], D, D, kb * 64, nb * 32, 32, (bf16_t*)(ws + WS_WOUT), nb * 32, scr, lane); continue; } r -= I_OUT;
            if (r < I_UP) { const int nb = r % 128, kb = r / 128; tr_item(p.in[16], FF, D, kb * 64, nb * 32, 32, (bf16_t*)(ws + WS_WUP), nb * 32, scr, lane); continue; } r -= I_UP;
            { const int nb = r % 32, kb = r / 32; tr_item(p.in[17], D, FF, kb * 64, nb * 32, 32, (bf16_t*)(ws + WS_WDN), nb * 32, scr, lane); }
        }
    }
}

__device__ __forceinline__ void norm_mod_vals(const f32x4 (&v)[4], const float* g, const float* sc, const float* sh, bf16_t* orow, int lane) {
    float s = 0.f;
#pragma unroll
    for (int j = 0; j < 4; ++j) s += (v[j][0] * v[j][0] + v[j][1] * v[j][1]) + (v[j][2] * v[j][2] + v[j][3] * v[j][3]);
    const float rstd = 1.0f / sqrtf(wave_sum(s) * (1.f / D) + EPS);
    unsigned long long* o8 = (unsigned long long*)orow + lane;
#pragma unroll
    for (int j = 0; j < 4; ++j) { const f32x4 gg = ((const f32x4*)g)[lane + 64 * j], ss = ((const f32x4*)sc)[lane + 64 * j], hh = ((const f32x4*)sh)[lane + 64 * j];
        const f32x4 y = (v[j] * rstd * gg) * (ss + 1.0f) + hh;
        o8[64 * j] = (unsigned long long)pk_bf16(y[0], y[1]) | ((unsigned long long)pk_bf16(y[2], y[3]) << 32); }
}

template <int NS> __device__ __forceinline__ void slab_row(const float* base, const float* gate, const float* slab, int r, int lane, f32x4 (&v)[4]) {
#pragma unroll
    for (int j = 0; j < 4; ++j) { f32x4 a = ((const f32x4*)(slab + (size_t)r * D))[lane + 64 * j];
#pragma unroll
        for (int ks = 1; ks < NS; ++ks) a += ((const f32x4*)(slab + ((size_t)ks * MS + r) * D))[lane + 64 * j];
        v[j] = ((const f32x4*)base)[lane + 64 * j] + ((const f32x4*)gate)[lane + 64 * j] * a; }
}
__device__ __forceinline__ void gla_decay_item(const Params& p, int it, int lane) {
    unsigned char* ws = p.ws;
    const int b = it >> 7, h = (it >> 5) & 3, c = it & 31, m0 = b * SEQ + c * 64, col = h * 64 + lane;
    const float* GZ = (const float*)(ws + WS_GZ); bf16_t* Q = (bf16_t*)(ws + WS_Q); bf16_t* K = (bf16_t*)(ws + WS_K); bf16_t* KOUT = (bf16_t*)(ws + WS_KOUT);
    float wg[16];
#pragma unroll
    for (int r = 0; r < 16; ++r) wg[r] = p.in[10][r * 256 + col];
    const float bgt = p.in[11][col];
    float last = 0.f;
#pragma unroll 4
    for (int t = 0; t < 64; ++t) {
        const float* gz = GZ + (size_t)(m0 + t) * 16; float z = bgt;
#pragma unroll
        for (int r = 0; r < 16; ++r) z += gz[r] * wg[r];
        last += logsigmoid_f(z) * (1.0f / 16.0f);
    }
    float run = 0.f;
#pragma unroll 1
    for (int tb = 0; tb < 8; ++tb) {
        float ko[8];
#pragma unroll
        for (int j = 0; j < 8; ++j) { const int t = tb * 8 + j; const size_t o = (size_t)(m0 + t) * 256 + col;
            const float* gz = GZ + (size_t)(m0 + t) * 16; float z = bgt;
#pragma unroll
            for (int r = 0; r < 16; ++r) z += gz[r] * wg[r];
            run += logsigmoid_f(z) * (1.0f / 16.0f);
            const float q = bf2f(Q[o]), k = bf2f(K[o]);
            const float qi = q * __expf(run), ki = k * __expf(-run); ko[j] = k * __expf(last - run);
            Q[o] = (bf16_t)(pk_bf16(qi, 0.f) & 0xffffu); K[o] = (bf16_t)(pk_bf16(ki, 0.f) & 0xffffu); }
        u32x4 w; w.x = pk_bf16(ko[0], ko[1]); w.y = pk_bf16(ko[2], ko[3]); w.z = pk_bf16(ko[4], ko[5]); w.w = pk_bf16(ko[6], ko[7]);
        *(u32x4*)(KOUT + ((size_t)it * 64 + lane) * 64 + tb * 8) = w;
    }
    ((float*)(ws + WS_DEC))[(size_t)it * 64 + lane] = __expf(last);
}
__device__ __forceinline__ void gla_vt_item(const Params& p, int it2, int lane) {
    unsigned char* ws = p.ws;
    const int it = it2 >> 1, vh = it2 & 1, b = it >> 7, h = (it >> 5) & 3, c = it & 31, m0 = b * SEQ + c * 64, v = vh * 64 + lane;
    const bf16_t* V = (const bf16_t*)(ws + WS_V) + (size_t)m0 * 512 + h * 128 + v; bf16_t* VT = (bf16_t*)(ws + WS_VT) + ((size_t)it * 128 + v) * 64;
#pragma unroll
    for (int sb = 0; sb < 8; ++sb) { unsigned short e[8];
#pragma unroll
        for (int j = 0; j < 8; ++j) e[j] = V[(size_t)(sb * 8 + j) * 512];
        u32x4 w; w.x = e[0] | ((unsigned)e[1] << 16); w.y = e[2] | ((unsigned)e[3] << 16); w.z = e[4] | ((unsigned)e[5] << 16); w.w = e[6] | ((unsigned)e[7] << 16);
        *(u32x4*)(VT + sb * 8) = w; }
}
__device__ __forceinline__ void gla_sample_item(const Params& p, int its, LAS float* L, int lane) {
    unsigned char* ws = p.ws;
    const int b = its >> 2, h = its & 3, mrow = MP + b * DSEQ;
    const float* GZ = (const float*)(ws + WS_GZ); const bf16_t* Q = (const bf16_t*)(ws + WS_Q); const bf16_t* K = (const bf16_t*)(ws + WS_K);
    const bf16_t* V = (const bf16_t*)(ws + WS_V); const bf16_t* R = (const bf16_t*)(ws + WS_R); bf16_t* HB = (bf16_t*)(ws + WS_HB);
    {
        const int col = h * 64 + lane; float wg[16];
#pragma unroll
        for (int r = 0; r < 16; ++r) wg[r] = p.in[10][r * 256 + col];
        const float bgt = p.in[11][col];
#pragma unroll
        for (int t = 0; t < 8; ++t) { const float* gz = GZ + (size_t)(mrow + t) * 16; float z = bgt;
#pragma unroll
            for (int r = 0; r < 16; ++r) z += gz[r] * wg[r];
            const float ld = logsigmoid_f(z) * (1.0f / 16.0f); const size_t o = (size_t)(mrow + t) * 256 + col;
            L[t * 64 + lane] = __expf(ld); L[512 + t * 64 + lane] = bf2f(K[o]); L[1024 + t * 64 + lane] = bf2f(Q[o]); }
        LDS_WAIT();
    }
    const float* S0p = p.in[2] + (size_t)its * 64 * 128; float* So = p.out + O_NGS + (size_t)its * 64 * 128;
#pragma unroll 1
    for (int hf = 0; hf < 2; ++hf) {
        float s0[64];
#pragma unroll
        for (int d = 0; d < 64; ++d) { const float* sp = S0p + hf * 64 + lane + (d >> 3) * 1024; if ((d & 7) == 0) asm volatile("" : "+v"(sp)); s0[d] = sp[(d & 7) * 128]; }
#pragma unroll 1
        for (int t = 0; t < 8; ++t) {
            const float v0 = bf2f(V[(size_t)(mrow + t) * 512 + h * 128 + hf * 64 + lane]); float o0 = 0.f;
#pragma unroll
            for (int d4 = 0; d4 < 16; ++d4) { const f32x4 a = *(const LAS f32x4*)(L + t * 64 + 4 * d4), k = *(const LAS f32x4*)(L + 512 + t * 64 + 4 * d4), q = *(const LAS f32x4*)(L + 1024 + t * 64 + 4 * d4);
#pragma unroll
                for (int j = 0; j < 4; ++j) { const int d = 4 * d4 + j; s0[d] = a[j] * s0[d] + k[j] * v0; o0 += q[j] * s0[d]; } }
            L[1536 + (hf * 8 + t) * 64 + lane] = o0;
        }
#pragma unroll
        for (int d = 0; d < 64; ++d) { float* sp = So + hf * 64 + lane + (d >> 3) * 1024; if ((d & 7) == 0) asm volatile("" : "+v"(sp)); sp[(d & 7) * 128] = s0[d]; }
    }
    LDS_WAIT();
    const float gn0 = p.in[12][h * 128 + lane], gn1 = p.in[12][h * 128 + 64 + lane];
#pragma unroll 1
    for (int t = 0; t < 8; ++t) {
        const float o0 = L[1536 + t * 64 + lane], o1 = L[1536 + (8 + t) * 64 + lane];
        const float rstd = 1.0f / sqrtf(wave_sum(o0 * o0 + o1 * o1) * (1.f / 128.f) + EPS);
        const size_t vo = (size_t)(mrow + t) * 512 + h * 128 + lane;
        const float r0 = bf2f(R[vo]), r1 = bf2f(R[vo + 64]);
        bf16_t* hp = HB + (size_t)(mrow + t) * D + h * 128 + lane;
        hp[0] = (bf16_t)(pk_bf16(o0 * rstd * gn0 * r0, 0.f) & 0xffffu); hp[64] = (bf16_t)(pk_bf16(o1 * rstd * gn1 * r1, 0.f) & 0xffffu);
    }
    LDS_WAIT();
}
__device__ __forceinline__ void conv_row(const Params& p, int m, int lane) {
    unsigned char* ws = p.ws;
    const bf16_t* U = (const bf16_t*)(ws + WS_U); const bf16_t* BG = (const bf16_t*)(ws + WS_BG); bf16_t* HB = (bf16_t*)(ws + WS_HB);
    const int ch = 8 * lane; const bool prompt = m < MP; const int t = prompt ? (m & (SEQ - 1)) : ((m - MP) & (DSEQ - 1)); const int b = prompt ? (m >> 11) : ((m - MP) >> 3);
    const int L = prompt ? SEQ : DSEQ;
    float u0[8], u1[8], u2[8], bg[8];
    { const u32x4 w = *(const u32x4*)(U + (size_t)m * 512 + ch); const u32x4 g = *(const u32x4*)(BG + (size_t)m * 512 + ch);
#pragma unroll
      for (int j = 0; j < 4; ++j) { u0[2 * j] = __uint_as_float(w[j] << 16); u0[2 * j + 1] = __uint_as_float(w[j] & 0xffff0000u); bg[2 * j] = __uint_as_float(g[j] << 16); bg[2 * j + 1] = __uint_as_float(g[j] & 0xffff0000u); } }
    const float* st = p.in[3] + (size_t)b * 2 * 512 + ch;
    if (t >= 1) { const u32x4 w = *(const u32x4*)(U + (size_t)(m - 1) * 512 + ch);
#pragma unroll
        for (int j = 0; j < 4; ++j) { u1[2 * j] = __uint_as_float(w[j] << 16); u1[2 * j + 1] = __uint_as_float(w[j] & 0xffff0000u); } }
    else {
#pragma unroll
        for (int j = 0; j < 8; ++j) u1[j] = prompt ? 0.f : st[512 + j]; }
    if (t >= 2) { const u32x4 w = *(const u32x4*)(U + (size_t)(m - 2) * 512 + ch);
#pragma unroll
        for (int j = 0; j < 4; ++j) { u2[2 * j] = __uint_as_float(w[j] << 16); u2[2 * j + 1] = __uint_as_float(w[j] & 0xffff0000u); } }
    else {
#pragma unroll
        for (int j = 0; j < 8; ++j) u2[j] = prompt ? 0.f : st[(t == 1 ? 512 : 0) + j]; }
    const float* wc = p.in[13] + ch; float y[8];
#pragma unroll
    for (int j = 0; j < 8; ++j) y[j] = bg[j] * (wc[j] * u2[j] + wc[512 + j] * u1[j] + wc[1024 + j] * u0[j]);
    u32x4 o; o.x = pk_bf16(y[0], y[1]); o.y = pk_bf16(y[2], y[3]); o.z = pk_bf16(y[4], y[5]); o.w = pk_bf16(y[6], y[7]);
    *(u32x4*)(HB + (size_t)m * D + 512 + ch) = o;
    if (t == L - 1) { float* nc = p.out + (prompt ? O_NCP : O_NCS) + (size_t)b * 2 * 512 + ch;
#pragma unroll
        for (int j = 0; j < 8; ++j) { nc[j] = u1[j]; nc[512 + j] = u0[j]; } }
}
__device__ __forceinline__ void gla_sloc_item(const Params& p, int it2, int lane) {
    unsigned char* ws = p.ws;
    const int it = it2 >> 1, vh = it2 & 1, fr = lane & 15, fq = lane >> 4;
    const bf16_t* VT = (const bf16_t*)(ws + WS_VT) + ((size_t)it * 128 + vh * 64) * 64; const bf16_t* KO = (const bf16_t*)(ws + WS_KOUT) + (size_t)it * 64 * 64;
    f32x4 acc[4][4];
#pragma unroll
    for (int a = 0; a < 4; ++a)
#pragma unroll
        for (int b = 0; b < 4; ++b) acc[a][b] = (f32x4){0.f, 0.f, 0.f, 0.f};
#pragma unroll
    for (int ks = 0; ks < 2; ++ks) { bf16x8 A[4], B[4];
#pragma unroll
        for (int i = 0; i < 4; ++i) { A[i] = *(const bf16x8*)(VT + (size_t)(16 * i + fr) * 64 + 32 * ks + 8 * fq); B[i] = *(const bf16x8*)(KO + (size_t)(16 * i + fr) * 64 + 32 * ks + 8 * fq); }
#pragma unroll
        for (int a = 0; a < 4; ++a)
#pragma unroll
            for (int b = 0; b < 4; ++b) acc[a][b] = __builtin_amdgcn_mfma_f32_16x16x32_bf16(A[a], B[b], acc[a][b], 0, 0, 0); }
    float* SL = (float*)(ws + WS_SLOC) + ((size_t)it * 128 + vh * 64) * 64;
#pragma unroll
    for (int a = 0; a < 4; ++a)
#pragma unroll
        for (int b = 0; b < 4; ++b)
#pragma unroll
            for (int i = 0; i < 4; ++i) SL[(size_t)(16 * a + 4 * fq + i) * 64 + 16 * b + fr] = acc[a][b][i];
}
__device__ __forceinline__ void gla_scan(const Params& p, int tid) {
    unsigned char* ws = p.ws;
    f32x4* SL = (f32x4*)(ws + WS_SLOC); const f32x4* DEC = (const f32x4*)(ws + WS_DEC);
    for (int idx = blockIdx.x * NTHR + tid; idx < 32 * 128 * 16; idx += gridDim.x * NTHR) {
        const int bh = idx >> 11, v = (idx >> 4) & 127, d4 = idx & 15;
        f32x4 S = (f32x4){0.f, 0.f, 0.f, 0.f};
#pragma unroll 8
        for (int c = 0; c < 32; ++c) { const size_t o = ((size_t)(bh * 32 + c) * 128 + v) * 16 + d4; const f32x4 t = SL[o], dc = DEC[(size_t)(bh * 32 + c) * 16 + d4]; SL[o] = S; S = dc * S + t; }
        float* ng = p.out + O_NGP + (size_t)bh * 64 * 128 + v;
#pragma unroll
        for (int i = 0; i < 4; ++i) ng[(size_t)(4 * d4 + i) * 128] = S[i];
    }
}
__device__ __forceinline__ void gla_out_item(const Params& p, int it2, int lane) {
    unsigned char* ws = p.ws;
    const int it = it2 >> 1, th = it2 & 1, fr = lane & 15, fq = lane >> 4;
    const int b = it >> 7, h = (it >> 5) & 3, c = it & 31, m0 = b * SEQ + c * 64;
    const bf16_t* Q = (const bf16_t*)(ws + WS_Q) + (size_t)m0 * 256 + h * 64; const bf16_t* K = (const bf16_t*)(ws + WS_K) + (size_t)m0 * 256 + h * 64;
    const bf16_t* VT = (const bf16_t*)(ws + WS_VT) + (size_t)it * 128 * 64; const float* ST = (const float*)(ws + WS_SLOC) + (size_t)it * 128 * 64;
    bf16x8 Bq[2][2];
#pragma unroll
    for (int tt = 0; tt < 2; ++tt)
#pragma unroll
        for (int ks = 0; ks < 2; ++ks) Bq[tt][ks] = *(const bf16x8*)(Q + (size_t)(32 * th + 16 * tt + fr) * 256 + 32 * ks + 8 * fq);
    u32x2 P[4][2];
#pragma unroll
    for (int st = 0; st < 4; ++st) {
        if (st < 2 + 2 * th) {
            f32x4 a0 = (f32x4){0.f, 0.f, 0.f, 0.f}, a1 = a0;
#pragma unroll
            for (int ks = 0; ks < 2; ++ks) { const bf16x8 Ak = *(const bf16x8*)(K + (size_t)(16 * st + fr) * 256 + 32 * ks + 8 * fq);
                a0 = __builtin_amdgcn_mfma_f32_16x16x32_bf16(Ak, Bq[0][ks], a0, 0, 0, 0); a1 = __builtin_amdgcn_mfma_f32_16x16x32_bf16(Ak, Bq[1][ks], a1, 0, 0, 0); }
            const int t0 = 32 * th + fr, t1 = t0 + 16;
#pragma unroll
            for (int i = 0; i < 4; ++i) { const int s = 16 * st + 4 * fq + i; a0[i] = (s <= t0) ? a0[i] : 0.f; a1[i] = (s <= t1) ? a1[i] : 0.f; }
            P[st][0].x = pk_bf16(a0[0], a0[1]); P[st][0].y = pk_bf16(a0[2], a0[3]); P[st][1].x = pk_bf16(a1[0], a1[1]); P[st][1].y = pk_bf16(a1[2], a1[3]);
        } else { P[st][0] = (u32x2){0u, 0u}; P[st][1] = (u32x2){0u, 0u}; }
    }
    f32x4 acc[8][2];
#pragma unroll
    for (int vt = 0; vt < 8; ++vt) { acc[vt][0] = (f32x4){0.f, 0.f, 0.f, 0.f}; acc[vt][1] = acc[vt][0]; }
#pragma unroll
    for (int kp = 0; kp < 2; ++kp) {
        if (kp < 1 + th) {
            bf16x8 Bp[2];
#pragma unroll
            for (int tt = 0; tt < 2; ++tt) { u32x4 w; w.x = P[2 * kp][tt].x; w.y = P[2 * kp][tt].y; w.z = P[2 * kp + 1][tt].x; w.w = P[2 * kp + 1][tt].y; Bp[tt] = __builtin_bit_cast(bf16x8, w); }
#pragma unroll
            for (int vt = 0; vt < 8; ++vt) { const bf16_t* vp = VT + (size_t)(16 * vt + fr) * 64 + 32 * kp + 4 * fq;
                const u32x2 lo = *(const u32x2*)vp, hi = *(const u32x2*)(vp + 16); u32x4 w; w.x = lo.x; w.y = lo.y; w.z = hi.x; w.w = hi.y; const bf16x8 Av = __builtin_bit_cast(bf16x8, w);
                acc[vt][0] = __builtin_amdgcn_mfma_f32_16x16x32_bf16(Av, Bp[0], acc[vt][0], 0, 0, 0); acc[vt][1] = __builtin_amdgcn_mfma_f32_16x16x32_bf16(Av, Bp[1], acc[vt][1], 0, 0, 0); }
        }
    }
#pragma unroll
    for (int ks = 0; ks < 2; ++ks)
#pragma unroll
        for (int vt = 0; vt < 8; ++vt) { const float* sp = ST + (size_t)(16 * vt + fr) * 64 + 32 * ks + 8 * fq; const f32x4 s0 = *(const f32x4*)sp, s1 = *(const f32x4*)(sp + 4);
            u32x4 w; w.x = pk_bf16(s0[0], s0[1]); w.y = pk_bf16(s0[2], s0[3]); w.z = pk_bf16(s1[0], s1[1]); w.w = pk_bf16(s1[2], s1[3]); const bf16x8 As = __builtin_bit_cast(bf16x8, w);
            acc[vt][0] = __builtin_amdgcn_mfma_f32_16x16x32_bf16(As, Bq[0][ks], acc[vt][0], 0, 0, 0); acc[vt][1] = __builtin_amdgcn_mfma_f32_16x16x32_bf16(As, Bq[1][ks], acc[vt][1], 0, 0, 0); }
    const bf16_t* R = (const bf16_t*)(ws + WS_R); bf16_t* HB = (bf16_t*)(ws + WS_HB); const float* gn = p.in[12] + h * 128;
#pragma unroll
    for (int tt = 0; tt < 2; ++tt) { float ss = 0.f;
#pragma unroll
        for (int vt = 0; vt < 8; ++vt) ss += (acc[vt][tt][0] * acc[vt][tt][0] + acc[vt][tt][1] * acc[vt][tt][1]) + (acc[vt][tt][2] * acc[vt][tt][2] + acc[vt][tt][3] * acc[vt][tt][3]);
        ss += __shfl_xor(ss, 16); ss += __shfl_xor(ss, 32);
        const float rstd = 1.0f / sqrtf(ss * (1.f / 128.f) + EPS);
        const int mrow = m0 + 32 * th + 16 * tt + fr;
#pragma unroll
        for (int vt = 0; vt < 8; ++vt) { const int v = 16 * vt + 4 * fq; const f32x4 g4 = *(const f32x4*)(gn + v); const u32x2 rw = *(const u32x2*)(R + (size_t)mrow * 512 + h * 128 + v);
            const float r0 = __uint_as_float(rw.x << 16), r1 = __uint_as_float(rw.x & 0xffff0000u), r2 = __uint_as_float(rw.y << 16), r3 = __uint_as_float(rw.y & 0xffff0000u);
            const f32x4 o = acc[vt][tt] * rstd * g4;
            u32x2 w; w.x = pk_bf16(o[0] * r0, o[1] * r1); w.y = pk_bf16(o[2] * r2, o[3] * r3);
            *(u32x2*)(HB + (size_t)mrow * D + h * 128 + v) = w; }
    }
}

#define RLX_AGENT __ATOMIC_RELAXED, __HIP_MEMORY_SCOPE_AGENT
#define XB_TMO      128
#define XB_XCNT(j)  (256  + 64 * (j))
#define XB_XSUB(j)  (1280 + 64 * (j))
#define XB_XGEN(j)  (2304 + 64 * (j))
#define XB_TOP      3328
#define XB_TOPGEN   3392
#define XCD_BAR_WORDS 3456
#define XB_SPIN_CAP (1u << 18)

__device__ __forceinline__ unsigned xb_ld(unsigned* p)              { return __hip_atomic_load(p, __ATOMIC_RELAXED, __HIP_MEMORY_SCOPE_AGENT); }
__device__ __forceinline__ unsigned xb_add(unsigned* p, unsigned v) { return __hip_atomic_fetch_add(p, v, __ATOMIC_RELAXED, __HIP_MEMORY_SCOPE_AGENT); }
__device__ __forceinline__ unsigned xb_xcc_id() { return (unsigned)__builtin_amdgcn_s_getreg((3 << 11) | 20) & 0xFu; }
#define XB_SPIN(cond, bar) do { unsigned _sp = 0; while (cond) { __builtin_amdgcn_s_sleep(1); \
    if ((++_sp & 255u) == 0u) { if (xb_ld(&(bar)[XB_TMO])) break; if (_sp > XB_SPIN_CAP) { atomicAdd(&(bar)[XB_TMO], 1u); break; } } } } while (0)

struct XcdBarrier {
    unsigned* bar; unsigned x;
    volatile LAS unsigned* st;
};

__device__ __forceinline__ XcdBarrier xcd_barrier_post(unsigned* bar, volatile LAS unsigned* st) {
    XcdBarrier b; b.bar = bar; b.x = xb_xcc_id(); b.st = st;
    if (threadIdx.x == 0) (void)xb_add(&bar[XB_XCNT(b.x)], 1u);
    return b;
}
__device__ __forceinline__ void xcd_barrier_complete(unsigned* bar, unsigned x, unsigned& nloc, unsigned& nx) {
    const unsigned G = gridDim.x * gridDim.y * gridDim.z;
    unsigned sum, cnt, mine, sp = 0u;
    for (;;) {
        sum = 0u; cnt = 0u; mine = 0u;
#pragma unroll
        for (unsigned j = 0; j < 16; ++j) { const unsigned c = xb_ld(&bar[XB_XCNT(j)]); sum += c; cnt += (c > 0u) ? 1u : 0u; mine = (j == x) ? c : mine; }
        if (sum == G) break;
        __builtin_amdgcn_s_sleep(1);
        if ((++sp & 255u) == 0u) { if (xb_ld(&bar[XB_TMO])) break; if (sp > XB_SPIN_CAP) { atomicAdd(&bar[XB_TMO], 1u); break; } }
    }
    nloc = mine > 0u ? mine : 1u; nx = cnt > 0u ? cnt : 1u;
}

__device__ __forceinline__ void xcd_barrier(const XcdBarrier& b) {
    asm volatile("s_waitcnt vmcnt(0)" ::: "memory");
    __syncthreads();
    if (threadIdx.x == 0) {
        unsigned* bar = b.bar;
        __builtin_amdgcn_s_waitcnt(0);
        unsigned nloc = b.st[0], nx = b.st[1];
        if (nloc == 0u) { xcd_barrier_complete(bar, b.x, nloc, nx); b.st[0] = nloc; b.st[1] = nx; }
        const unsigned old = xb_add(&bar[XB_XSUB(b.x)], 1u);
        const unsigned gen = old / nloc;
        if (old + 1u == (gen + 1u) * nloc) {
            __builtin_amdgcn_fence(__ATOMIC_RELEASE, "agent");
            asm volatile("s_waitcnt vmcnt(0)" ::: "memory");
            const unsigned og = xb_add(&bar[XB_TOP], 1u);
            const unsigned tg = og / nx;
            if (og + 1u == (tg + 1u) * nx) xb_add(&bar[XB_TOPGEN], 1u);
            else XB_SPIN(xb_ld(&bar[XB_TOPGEN]) == tg, bar);
            __builtin_amdgcn_fence(__ATOMIC_ACQUIRE, "agent");
            xb_add(&bar[XB_XGEN(b.x)], 1u);
            asm volatile("s_waitcnt vmcnt(0)" ::: "memory");
        } else {
            XB_SPIN(xb_ld(&bar[XB_XGEN(b.x)]) == gen, bar);
            __builtin_amdgcn_fence(__ATOMIC_ACQUIRE, "agent");
            asm volatile("s_waitcnt vmcnt(0)" ::: "memory");
        }
    }
    __syncthreads();
}

#ifndef MK_SKIP
#define MK_SKIP 0
#endif
__global__ void __launch_bounds__(NTHR, 2) mk_fwd(Params p) {
    extern __shared__ __attribute__((aligned(16))) unsigned char lds_raw[];
    LAS unsigned char* lds = (LAS unsigned char*)lds_raw;
    cg::grid_group grid = cg::this_grid();
    const int tid = threadIdx.x, lane = tid & 63, wave = __builtin_amdgcn_readfirstlane(tid >> 6);
    const int G = gridDim.x, gw = blockIdx.x * NWAVES + wave, NGW = G * NWAVES;
    unsigned char* ws = p.ws;
    float* MOD = (float*)(ws + WS_MOD); bf16_t* HB = (bf16_t*)(ws + WS_HB); float* Y = p.out + O_Y;
    const int lo = p.ph_lo, hi = p.ph_hi;
    if (tid < 64) ((LAS unsigned*)(lds + LDS_CTL_OFF))[tid] = 0u;
    __syncthreads();
    XcdBarrier bar = xcd_barrier_post((unsigned*)ws, (volatile LAS unsigned*)(lds + LDS_CTL_OFF));
    if (lo < 0) grid.sync();
#define IN(k) (lo <= (k) && (k) < hi)
#define SEAM(k) do { if (IN(k) && IN((k) + 1)) xcd_barrier(bar); } while (0)

    if (IN(0) && !(MK_SKIP & (1 << 0))) phase_prep(p, lds, tid, wave, lane);
    SEAM(0);
    if (IN(1) && !(MK_SKIP & (1 << 1))) {
        for (int m = gw; m < M; m += NGW) { const int bi = batch_of_row(m); const float* xr = m < MP ? p.in[0] + (size_t)m * D : p.in[1] + (size_t)(m - MP) * D; const float* md = MOD + (size_t)bi * NMOD;
            f32x4 v[4];
#pragma unroll
            for (int j = 0; j < 4; ++j) v[j] = ((const f32x4*)xr)[lane + 64 * j];
            norm_mod_vals(v, p.in[8], md + 1024, md, HB + (size_t)m * D, lane); }
    }
    SEAM(1);
    if (IN(2) && !(MK_SKIP & (1 << 2))) {
        pg8::Gemm g{HB, (const bf16_t*)(ws + WS_WIN), M, NIN, D, D}; pg8::StaticOrder S; S.init(M, NIN, G, (int)blockIdx.x);
        EpiIn E{(bf16_t*)(ws + WS_Q), (bf16_t*)(ws + WS_K), (bf16_t*)(ws + WS_V), (bf16_t*)(ws + WS_R), (bf16_t*)(ws + WS_BG), (bf16_t*)(ws + WS_U), (float*)(ws + WS_GZ)};
        pg8::gemm_phase<EpiIn, pg8::StaticOrder, true, true>(lds, g, S, E);
    }
    SEAM(2);
    if (IN(3) && !(MK_SKIP & (1 << 3))) {
        LAS float* L = (LAS float*)(lds + wave * 16384);
        constexpr int N_DEC = 1024, N_VT = 2048, N_SMP = 512;
        for (int it = gw; it < N_DEC + N_VT + N_SMP + M; it += NGW) {
            int r = it;
            if (r < N_DEC) { gla_decay_item(p, r, lane); continue; } r -= N_DEC;
            if (r < N_VT) { gla_vt_item(p, r, lane); continue; } r -= N_VT;
            if (r < N_SMP) { gla_sample_item(p, r, L, lane); continue; } r -= N_SMP;
            conv_row(p, r, lane);
        }
    }
    SEAM(3);
    if (IN(4) && !(MK_SKIP & (1 << 4))) { for (int it = gw; it < 2048; it += NGW) gla_sloc_item(p, it, lane); }
    SEAM(4);
    if (IN(5) && !(MK_SKIP & (1 << 5))) gla_scan(p, tid);
    SEAM(5);
    if (IN(6) && !(MK_SKIP & (1 << 6))) { for (int it = gw; it < 2048; it += NGW) gla_out_item(p, it, lane); }
    SEAM(6);
    if (IN(7) && !(MK_SKIP & (1 << 7))) {
        { pg8::Gemm g{HB, (const bf16_t*)(ws + WS_WOUT), MP, D, D, D}; pg8::StaticOrder S; S.init(MP, D, G, (int)blockIdx.x);
          EpiRes<true> E{p.in[0], p.in[1], Y, MOD + 2048};
          pg8::gemm_phase<EpiRes<true>, pg8::StaticOrder, true, true>(lds, g, S, E); }
        { pg8::Gemm g{HB, (const bf16_t*)(ws + WS_WOUT), M, D, 256, D}; pg8::SplitOrder S; S.init(MP / 256, MS / 256, D / 256, 4, 256, G, (int)blockIdx.x);
          EpiSlab E{(float*)(ws + WS_SLAB), 256};
          pg8::gemm_phase<EpiSlab, pg8::SplitOrder, true, true>(lds, g, S, E); }
    }
    SEAM(7);
    if (IN(8) && !(MK_SKIP & (1 << 8))) {
        for (int m = gw; m < M; m += NGW) { const int bi = batch_of_row(m); const float* md = MOD + (size_t)bi * NMOD;
            f32x4 v[4];
            if (m < MP) {
#pragma unroll
                for (int j = 0; j < 4; ++j) v[j] = ((const f32x4*)(Y + (size_t)m * D))[lane + 64 * j];
            } else { slab_row<4>(p.in[1] + (size_t)(m - MP) * D, md + 2048, (const float*)(ws + WS_SLAB), m - MP, lane, v);
#pragma unroll
                for (int j = 0; j < 4; ++j) ((f32x4*)(Y + (size_t)m * D))[lane + 64 * j] = v[j]; }
            norm_mod_vals(v, p.in[15], md + 4096, md + 3072, HB + (size_t)m * D, lane); }
    }
    SEAM(8);
    if (IN(9) && !(MK_SKIP & (1 << 9))) {
        pg8::Gemm g{HB, (const bf16_t*)(ws + WS_WUP), M, FF, D, D}; pg8::StaticOrder S; S.init(M, FF, G, (int)blockIdx.x);
        EpiUp E{(bf16_t*)(ws + WS_ACT)};
        pg8::gemm_phase<EpiUp, pg8::StaticOrder, true, true>(lds, g, S, E);
    }
    SEAM(9);
    if (IN(10) && !(MK_SKIP & (1 << 10))) {
        { pg8::Gemm g{(const bf16_t*)(ws + WS_ACT), (const bf16_t*)(ws + WS_WDN), MP, D, FF, FF}; pg8::StaticOrder S; S.init(MP, D, G, (int)blockIdx.x);
          EpiRes<false> E{nullptr, nullptr, Y, MOD + 5120};
          pg8::gemm_phase<EpiRes<false>, pg8::StaticOrder, true, true>(lds, g, S, E); }
        { pg8::Gemm g{(const bf16_t*)(ws + WS_ACT), (const bf16_t*)(ws + WS_WDN), M, D, 512, FF}; pg8::SplitOrder S; S.init(MP / 256, MS / 256, D / 256, 8, 512, G, (int)blockIdx.x);
          EpiSlab E{(float*)(ws + WS_SLAB), 512};
          pg8::gemm_phase<EpiSlab, pg8::SplitOrder, true, true>(lds, g, S, E); }
    }
    SEAM(10);
    if (IN(11) && !(MK_SKIP & (1 << 11))) {
        const float* fg = p.in[18];
        for (int m = gw; m < M; m += NGW) { f32x4* xr = (f32x4*)(Y + (size_t)m * D) + lane; f32x4 v[4]; float s = 0.f;
            if (m < MP) {
#pragma unroll
                for (int j = 0; j < 4; ++j) v[j] = xr[64 * j];
            } else slab_row<8>(Y + (size_t)m * D, MOD + (size_t)batch_of_row(m) * NMOD + 5120, (const float*)(ws + WS_SLAB), m - MP, lane, v);
#pragma unroll
            for (int j = 0; j < 4; ++j) s += (v[j][0] * v[j][0] + v[j][1] * v[j][1]) + (v[j][2] * v[j][2] + v[j][3] * v[j][3]);
            const float rstd = 1.0f / sqrtf(wave_sum(s) * (1.f / D) + EPS);
#pragma unroll
            for (int j = 0; j < 4; ++j) xr[64 * j] = v[j] * rstd * ((const f32x4*)fg)[lane + 64 * j]; }
    }
#undef IN
#undef SEAM
}

#ifndef MK_SPLIT

#define MK_SPLIT 0
#endif
constexpr int N_PHASES = 12;
extern "C" void kernel_launch(void* const* d_in, const int* in_sizes, int n_in, void* d_out, int out_size, void* d_ws, size_t ws_size, hipStream_t stream) {
    static int grid = 0;
    if (grid == 0) {
        int dev = 0, cus = 0, per_cu = 0;
        if (hipGetDevice(&dev) != hipSuccess || hipDeviceGetAttribute(&cus, hipDeviceAttributeMultiprocessorCount, dev) != hipSuccess) { fprintf(stderr, "kernel_launch: device query failed\n"); grid = -1; return; }
        if (hipFuncSetAttribute((const void*)mk_fwd, hipFuncAttributeMaxDynamicSharedMemorySize, LDS_BYTES) != hipSuccess) { fprintf(stderr, "kernel_launch: hipFuncSetAttribute failed\n"); grid = -1; return; }
        if (hipOccupancyMaxActiveBlocksPerMultiprocessor(&per_cu, (const void*)mk_fwd, NTHR, LDS_BYTES) != hipSuccess || per_cu < 1) { fprintf(stderr, "kernel_launch: occupancy query says %d\n", per_cu); per_cu = 1; }
        (void)hipGetLastError();
        grid = cus;
        if (n_in != 19 || ws_size < WS_END || (size_t)ws_size < WS_ACT + (size_t)M * FF * 2) { fprintf(stderr, "kernel_launch: unexpected n_in %d / ws %zu\n", n_in, ws_size); grid = -1; return; }
    }
    if (grid < 0) return;
    if (hipMemsetAsync(d_ws, 0, 16384, stream) != hipSuccess) { fprintf(stderr, "kernel_launch: memset failed\n"); return; }
    Params p{};
    for (int i = 0; i < 19; ++i) p.in[i] = (const float*)d_in[i];
    p.out = (float*)d_out; p.ws = (unsigned char*)d_ws;
#if MK_SPLIT
    for (int ph = 0; ph < N_PHASES; ++ph) { p.ph_lo = ph; p.ph_hi = ph + 1; hipLaunchKernelGGL(mk_fwd, dim3(grid), dim3(NTHR), LDS_BYTES, stream, p); }
#else
    p.ph_lo = 0; p.ph_hi = N_PHASES;
    void* args[] = {&p};
    hipError_t e = hipLaunchCooperativeKernel((const void*)mk_fwd, dim3(grid), dim3(NTHR), args, LDS_BYTES, stream);
    if (e != hipSuccess) fprintf(stderr, "kernel_launch: cooperative launch failed: %s (grid %d)\n", hipGetErrorString(e), grid);
#endif
}
```

```cpp
#include <hip/hip_runtime.h>
#include <hip/hip_cooperative_groups.h>
#include <cstdio>
#include <cstdint>
namespace cg = cooperative_groups;
namespace pg8 {
#define PG8_LAS __attribute__((address_space(3)))
typedef unsigned short bf16_t;
typedef short bf16x8 __attribute__((ext_vector_type(8)));
typedef float f32x4 __attribute__((ext_vector_type(4)));
typedef unsigned u32x4 __attribute__((ext_vector_type(4)));
constexpr int BM = 256, BK = 64, HALF = 128, HTB = HALF * BK * 2  , STAGE_BYTES = 8 * HTB, NXCD = 8, WGM = 8;

__host__ __device__ __forceinline__ int lds_byte(int r, int c) { const int st = (r >> 4) * 2 + (c >> 5), rr = r & 15, cc = c & 31, ob = rr * 64 + cc * 2; return st * 1024 + (ob ^ (((ob >> 9) & 1) << 5)); }
__host__ __device__ __forceinline__ void stage_rc(int b, int& R, int& C) { const int st = b / 1024, sb = b % 1024, swz = sb ^ (((sb >> 9) & 1) << 5); R = (st >> 1) * 16 + swz / 64; C = (st & 1) * 32 + (swz % 64) / 2; }
__host__ __device__ __forceinline__ int perm32(int rho) { const int n = rho >> 4, i = rho & 15; return 8 * (i >> 2) + 4 * n + (i & 3); }

struct Unit { int pm, pn, kof; };
struct Gemm { const bf16_t* A; const bf16_t* Bt; int M, N, K, ld; };

struct StaticOrder {
    int nM, nN, nwg, G, c;
    __host__ __device__ void init(int M, int N, int G_, int c_) { nM = M / BM; nN = N / BM; nwg = nM * nN; G = G_; c = c_; }
    __host__ __device__ bool next(int i, Unit& u) const {
        const long L = (long)i * G + c; if (L >= nwg) return false;
        int wgid = (int)L; { const int q = nwg / NXCD, r = nwg % NXCD, xcd = wgid % NXCD, off = wgid / NXCD; wgid = (xcd < r ? xcd * (q + 1) : r * (q + 1) + (xcd - r) * q) + off; }
        const int nig = WGM * nN, gid = wgid / nig, fm = gid * WGM, gsz = (nM - fm) < WGM ? (nM - fm) : WGM;
        u.pm = fm + ((wgid % nig) % gsz); u.pn = (wgid % nig) / gsz; u.kof = 0; return true;
    }
    __device__ __forceinline__ void a_ready(const Unit&) const {}
    __device__ __forceinline__ void done(const Unit&) const {}
};

struct SplitOrder {
    int pm0, nN, nsplit, kslice, nitems, G, c;
    __host__ __device__ void init(int pm0_, int npm, int nN_, int nsplit_, int kslice_, int G_, int c_) { pm0 = pm0_; nN = nN_; nsplit = nsplit_; kslice = kslice_; nitems = npm * nN_ * nsplit_; G = G_; c = c_; }
    __host__ __device__ bool next(int i, Unit& u) const { const long L = (long)i * G + c; if (L >= nitems) return false; const int l = (int)L, ks = l % nsplit, t = l / nsplit; u.pn = t % nN; u.pm = pm0 + t / nN; u.kof = ks * kslice; return true; }
    __device__ __forceinline__ void a_ready(const Unit&) const {}
    __device__ __forceinline__ void done(const Unit&) const {}
};

__device__ __forceinline__ unsigned cvt_pk_bf16(float lo, float hi) { unsigned r; asm volatile("v_cvt_pk_bf16_f32 %0, %1, %2" : "=v"(r) : "v"(lo), "v"(hi)); return r; }
template <class Epi, class Sched, bool ALIGN_EPI = false, bool SP2 = false>
__device__ __forceinline__ void gemm_phase(PG8_LAS unsigned char* lds, const Gemm g, const Sched& S, const Epi& E) {
    const int tid = threadIdx.x, wid = __builtin_amdgcn_readfirstlane(tid >> 6), lane = tid & 63, wr = wid >> 2, wc = wid & 3, fr = lane & 15, fq = lane >> 4;
    const int K = g.ld, nt = g.K / BK;
    unsigned voffA[2], voffB[2];
#pragma unroll
    for (int i = 0; i < 2; ++i) { int R, C; stage_rc(tid * 16 + i * 8192, R, C); const int Rb = Epi::PERM ? ((R & ~31) + perm32(R & 31)) : R;
        voffA[i] = (unsigned)(R * K + C) * 2u; voffB[i] = (unsigned)(Rb * K + C) * 2u; }
    const size_t kstep = (size_t)(BK * 2);
    const size_t hstep = (size_t)HALF * K * 2;
    const size_t tstep = 2 * hstep;
    const unsigned ldsw = (unsigned)wid * 1024u;
    const int aoff = lds_byte(wr * 64 + fr, fq * 8), boff = lds_byte(wc * 32 + fr, fq * 8);
#define PG8_SA(b, h) (((b) * 2 + (h)) * HTB)
#define PG8_SB(b, h) ((4 + (b) * 2 + (h)) * HTB)
#define PG8_STAGE(bufoff, gbase, voff) do { _Pragma("unroll") for (int _i = 0; _i < 2; ++_i) \
        __builtin_amdgcn_global_load_lds((const unsigned*)((const char*)(gbase) + (voff)[_i]), (PG8_LAS unsigned*)(lds + (bufoff) + ldsw + _i * 8192), 16, 0, 0); } while (0)
#define PG8_LDA(dst, b, h) do { _Pragma("unroll") for (int m = 0; m < 4; ++m) _Pragma("unroll") for (int k = 0; k < 2; ++k) dst[m][k] = *(const PG8_LAS bf16x8*)(lds + PG8_SA(b, h) + aoff + m * 2048 + k * 1024); } while (0)
#define PG8_LDB(dst, b, h) do { _Pragma("unroll") for (int n = 0; n < 2; ++n) _Pragma("unroll") for (int k = 0; k < 2; ++k) dst[n][k] = *(const PG8_LAS bf16x8*)(lds + PG8_SB(b, h) + boff + n * 2048 + k * 1024); } while (0)
#define PG8_MMA(ai, bj, At, Bt) do { __builtin_amdgcn_s_setprio(1); _Pragma("unroll") for (int m = 0; m < 4; ++m) _Pragma("unroll") for (int n = 0; n < 2; ++n) _Pragma("unroll") for (int k = 0; k < 2; ++k) \
        acc[ai][bj][m][n] = __builtin_amdgcn_mfma_f32_16x16x32_bf16(Bt[n][k], At[m][k], acc[ai][bj][m][n], 0, 0, 0); __builtin_amdgcn_s_setprio(0); } while (0)
#define PG8_WAIT_V(n) asm volatile("s_waitcnt vmcnt(" #n ")" ::: "memory")
#define PG8_WAIT_L(n) asm volatile("s_waitcnt lgkmcnt(" #n ")" ::: "memory")
#define PG8_BAR __builtin_amdgcn_s_barrier()
#define PG8_SCHED __builtin_amdgcn_sched_barrier(0)
    Unit cur, nxt; int ui = 0;
    if (!S.next(0, cur)) return;
    f32x4 acc[2][2][4][2];
#pragma unroll
    for (int a = 0; a < 2; ++a)
#pragma unroll
        for (int b = 0; b < 2; ++b)
#pragma unroll
            for (int m = 0; m < 4; ++m)
#pragma unroll
                for (int n = 0; n < 2; ++n) acc[a][b][m][n] = (f32x4){0.f, 0.f, 0.f, 0.f};
    bf16x8 At[4][2], B0[2][2], B1[2][2];
    const char* cA = (const char*)g.A + (size_t)cur.pm * tstep + (size_t)cur.kof * 2; const char* cB = (const char*)g.Bt + (size_t)cur.pn * tstep + (size_t)cur.kof * 2;
    S.a_ready(cur);
    if constexpr (SP2) {
        PG8_STAGE(PG8_SB(0, 0), cB, voffB); PG8_STAGE(PG8_SB(0, 1), cB + hstep, voffB); PG8_STAGE(PG8_SA(0, 0), cA, voffA); PG8_STAGE(PG8_SA(0, 1), cA + hstep, voffA);
        if (wr == 1) PG8_BAR;
        PG8_WAIT_V(2); PG8_BAR;
        PG8_STAGE(PG8_SB(1, 0), cB + kstep, voffB); PG8_STAGE(PG8_SA(1, 0), cA + kstep, voffA); PG8_STAGE(PG8_SB(1, 1), cB + hstep + kstep, voffB);
        PG8_WAIT_V(6); PG8_BAR;
    } else {
        PG8_STAGE(PG8_SB(0, 0), cB, voffB); PG8_STAGE(PG8_SA(0, 0), cA, voffA); PG8_STAGE(PG8_SB(0, 1), cB + hstep, voffB); PG8_STAGE(PG8_SA(0, 1), cA + hstep, voffA);
        if (wr == 1) PG8_BAR;
        PG8_WAIT_V(4); PG8_BAR;
        PG8_STAGE(PG8_SB(1, 0), cB + kstep, voffB); PG8_STAGE(PG8_SA(1, 0), cA + kstep, voffA); PG8_STAGE(PG8_SB(1, 1), cB + hstep + kstep, voffB);
        PG8_WAIT_V(6); PG8_BAR;
    }
    for (;;) {
        const bool has_next = S.next(ui + 1, nxt);
        const char* nA = has_next ? (const char*)g.A + (size_t)nxt.pm * tstep + (size_t)nxt.kof * 2 : cA; const char* nB = has_next ? (const char*)g.Bt + (size_t)nxt.pn * tstep + (size_t)nxt.kof * 2 : cB;
        for (int t = 0; t < nt; t += 2) {
            const bool last = (t == nt - 2);
            const char* a1 = cA + (size_t)(t + 1) * kstep;
            const char* a2 = last ? nA : cA + (size_t)(t + 2) * kstep; const char* b2 = last ? nB : cB + (size_t)(t + 2) * kstep;
            const char* a3 = a2 + kstep; const char* b3 = b2 + kstep;
            if (last && has_next) S.a_ready(nxt);
            if constexpr (SP2) {
            PG8_LDB(B0, 0, 0); PG8_LDB(B1, 0, 1); PG8_SCHED; PG8_LDA(At, 0, 0); PG8_STAGE(PG8_SA(1, 1), a1 + hstep, voffA);
            PG8_WAIT_V(8); PG8_WAIT_L(0); PG8_BAR; PG8_MMA(0, 0, At, B0); PG8_MMA(0, 1, At, B1); PG8_BAR; PG8_SCHED;
            PG8_LDA(At, 0, 1); PG8_STAGE(PG8_SB(0, 0), b2, voffB); PG8_STAGE(PG8_SB(0, 1), b2 + hstep, voffB); PG8_STAGE(PG8_SA(0, 0), a2, voffA);
            PG8_WAIT_V(8); PG8_WAIT_L(0); PG8_BAR; PG8_MMA(1, 0, At, B0); PG8_MMA(1, 1, At, B1); PG8_BAR; PG8_SCHED;
            PG8_LDB(B0, 1, 0); PG8_LDB(B1, 1, 1); PG8_SCHED; PG8_LDA(At, 1, 0); PG8_STAGE(PG8_SA(0, 1), a2 + hstep, voffA);
            PG8_WAIT_V(8); PG8_WAIT_L(0); PG8_BAR; PG8_MMA(0, 0, At, B0); PG8_MMA(0, 1, At, B1); PG8_BAR; PG8_SCHED;
            PG8_LDA(At, 1, 1); PG8_STAGE(PG8_SB(1, 0), b3, voffB); PG8_STAGE(PG8_SB(1, 1), b3 + hstep, voffB); PG8_STAGE(PG8_SA(1, 0), a3, voffA);
            PG8_WAIT_V(8); PG8_WAIT_L(0); PG8_BAR; PG8_MMA(1, 0, At, B0); PG8_MMA(1, 1, At, B1); PG8_BAR; PG8_SCHED;
            } else {
            PG8_LDB(B0, 0, 0); PG8_SCHED; PG8_LDA(At, 0, 0); PG8_STAGE(PG8_SA(1, 1), a1 + hstep, voffA);
            PG8_WAIT_L(8); PG8_BAR; PG8_WAIT_L(0); PG8_MMA(0, 0, At, B0); PG8_BAR; PG8_SCHED;
            PG8_LDB(B1, 0, 1); PG8_STAGE(PG8_SB(0, 0), b2, voffB);
            PG8_BAR; PG8_WAIT_L(0); PG8_MMA(0, 1, At, B1); PG8_BAR;
            PG8_LDA(At, 0, 1); PG8_STAGE(PG8_SA(0, 0), a2, voffA);
            PG8_BAR; PG8_WAIT_L(0); PG8_MMA(1, 0, At, B0); PG8_BAR; PG8_SCHED;
            PG8_STAGE(PG8_SB(0, 1), b2 + hstep, voffB);
            PG8_WAIT_V(6); PG8_BAR; PG8_MMA(1, 1, At, B1); PG8_BAR;
            PG8_LDB(B0, 1, 0); PG8_SCHED; PG8_LDA(At, 1, 0); PG8_STAGE(PG8_SA(0, 1), a2 + hstep, voffA);
            PG8_WAIT_L(8); PG8_BAR; PG8_WAIT_L(0); PG8_MMA(0, 0, At, B0); PG8_BAR; PG8_SCHED;
            PG8_LDB(B1, 1, 1); PG8_STAGE(PG8_SB(1, 0), b3, voffB);
            PG8_BAR; PG8_WAIT_L(0); PG8_MMA(0, 1, At, B1); PG8_BAR;
            PG8_LDA(At, 1, 1); PG8_STAGE(PG8_SA(1, 0), a3, voffA);
            PG8_BAR; PG8_WAIT_L(0); PG8_MMA(1, 0, At, B0); PG8_BAR; PG8_SCHED;
            PG8_STAGE(PG8_SB(1, 1), b3 + hstep, voffB);
            PG8_WAIT_V(6); PG8_BAR; PG8_MMA(1, 1, At, B1); PG8_BAR;
            }
        }
        if constexpr (ALIGN_EPI) { if (wr == 0) PG8_BAR; }
        if constexpr (!Epi::AFTER_DRAIN) { E(acc, cur, wr, wc, fr, fq); S.done(cur); }
        if (!has_next) break;
#pragma unroll
        for (int a = 0; a < 2; ++a)
#pragma unroll
            for (int b = 0; b < 2; ++b)
#pragma unroll
                for (int m = 0; m < 4; ++m)
#pragma unroll
                    for (int n = 0; n < 2; ++n) acc[a][b][m][n] = (f32x4){0.f, 0.f, 0.f, 0.f};
        cur = nxt; cA = nA; cB = nB; ++ui;
        if constexpr (ALIGN_EPI) { if (wr == 1) PG8_BAR; }
    }
    PG8_WAIT_V(0);
    if constexpr (!ALIGN_EPI) { if (wr == 0) PG8_BAR; }
    PG8_BAR;
    if constexpr (Epi::AFTER_DRAIN) { E.fused(acc, cur, wr, wc, fr, fq, lds, wid, lane); S.done(cur); }
#undef PG8_SA
#undef PG8_SB
#undef PG8_STAGE
#undef PG8_LDA
#undef PG8_LDB
#undef PG8_MMA
#undef PG8_WAIT_V
#undef PG8_WAIT_L
#undef PG8_BAR
#undef PG8_SCHED
}
}

#define LAS __attribute__((address_space(3)))
typedef unsigned short bf16_t;
typedef short bf16x8 __attribute__((ext_vector_type(8)));
typedef short bf16x4 __attribute__((ext_vector_type(4)));
typedef float f32x4 __attribute__((ext_vector_type(4)));
typedef unsigned u32x4 __attribute__((ext_vector_type(4)));
typedef unsigned u32x2 __attribute__((ext_vector_type(2)));

constexpr int NTHR = 512, NWAVES = 8;
constexpr int D = 1024, MP = 16384, MS = 1024, M = MP + MS, NBATCH = 136, NIN = 3328, FF = 4096, NMOD = 6144;
constexpr int SEQ = 2048, DSEQ = 8;
constexpr float EPS = 1e-6f;
constexpr size_t HM = 524288;
constexpr size_t WS_MOD = 2 * HM, WS_WIN = 10 * HM, WS_WOUT = 24 * HM, WS_WUP = 28 * HM, WS_WDN = 44 * HM, WS_HB = 60 * HM;
constexpr size_t WS_ACT = 128 * HM;
constexpr size_t WS_Q = 128 * HM, WS_K = 145 * HM, WS_V = 162 * HM, WS_R = 196 * HM, WS_BG = 230 * HM, WS_U = 264 * HM, WS_GZ = 298 * HM;
constexpr size_t WS_KOUT = 302 * HM, WS_VT = 318 * HM, WS_SLOC = 350 * HM, WS_DEC = 414 * HM, WS_SLAB = 416 * HM, WS_END = 480 * HM;
static_assert(WS_ACT + (size_t)M * FF * 2 <= 512 * HM && WS_END <= 512 * HM, "workspace map");
constexpr size_t O_Y = 0, O_NGP = (size_t)M * D, O_NCP = O_NGP + 8 * 4 * 64 * 128, O_NGS = O_NCP + 8 * 2 * 512, O_NCS = O_NGS + (size_t)128 * 4 * 64 * 128;
constexpr int LDS_BYTES = 135168, LDS_CTL_OFF = 131072;

struct Params {
    const float* in[19];
    float* out; unsigned char* ws;
    int ph_lo, ph_hi;
};

__device__ __forceinline__ float bf2f(unsigned short b) { return __uint_as_float(((unsigned)b) << 16); }
typedef float f32x2_t __attribute__((ext_vector_type(2)));
typedef __bf16 bf16x2_t __attribute__((ext_vector_type(2)));
__device__ __forceinline__ unsigned pk_bf16(float lo, float hi) { const f32x2_t v = {lo, hi}; return __builtin_bit_cast(unsigned, __builtin_convertvector(v, bf16x2_t)); }
__device__ __forceinline__ float wave_sum(float v) {
#pragma unroll
    for (int o = 1; o < 64; o <<= 1) v += __shfl_xor(v, o);
    return v;
}
__device__ __forceinline__ float silu_f(float x) { return x * __builtin_amdgcn_rcpf(1.0f + __expf(-x)); }
__device__ __forceinline__ float logsigmoid_f(float z) { return fminf(z, 0.f) - __logf(1.0f + __expf(-fabsf(z))); }
__device__ __forceinline__ int batch_of_row(int m) { return m < MP ? (m >> 11) : 8 + ((m - MP) >> 3); }
#define LDS_WAIT() asm volatile("s_waitcnt lgkmcnt(0)" ::: "memory")

struct EpiIn {
    static constexpr bool PERM = true, AFTER_DRAIN = false;
    bf16_t *Q, *K, *V, *R, *BG, *U; float* GZ;
    __device__ __forceinline__ void operator()(const f32x4 (&acc)[2][2][4][2], const pg8::Unit& u, int wr, int wc, int fr, int fq) const {
        const int row0 = u.pm * 256 + wr * 64 + fr, cl = wc * 32 + 8 * fq, pn = u.pn;
        if (pn < 8) {
            bf16_t* base; int ldc, colt; float sc = 1.f; bool act = false;
            if (pn == 0) { base = Q; ldc = 256; colt = 0; sc = 0.125f; }
            else if (pn == 1) { base = K; ldc = 256; colt = 0; }
            else if (pn < 4) { base = V; ldc = 512; colt = (pn - 2) * 256; }
            else if (pn < 6) { base = R; ldc = 512; colt = (pn - 4) * 256; act = true; }
            else { base = BG; ldc = 512; colt = (pn - 6) * 256; }
#pragma unroll
            for (int ai = 0; ai < 2; ++ai)
#pragma unroll
                for (int m = 0; m < 4; ++m) { bf16_t* rowp = base + (size_t)(row0 + ai * 128 + m * 16) * ldc + colt + cl;
#pragma unroll
                    for (int bj = 0; bj < 2; ++bj) { f32x4 v0 = acc[ai][bj][m][0] * sc, v1 = acc[ai][bj][m][1] * sc;
                        if (act) {
#pragma unroll
                            for (int j = 0; j < 4; ++j) { v0[j] = silu_f(v0[j]); v1[j] = silu_f(v1[j]); } }
                        u32x4 w; w.x = pk_bf16(v0[0], v0[1]); w.y = pk_bf16(v0[2], v0[3]); w.z = pk_bf16(v1[0], v1[1]); w.w = pk_bf16(v1[2], v1[3]);
                        *(u32x4*)(rowp + bj * 128) = w; } }
        } else if (pn < 12) {
            const int j0 = (pn - 8) * 128 + cl;
#pragma unroll
            for (int ai = 0; ai < 2; ++ai)
#pragma unroll
                for (int m = 0; m < 4; ++m) { bf16_t* rowp = U + (size_t)(row0 + ai * 128 + m * 16) * 512 + j0;
                    const f32x4 v0 = acc[ai][0][m][0] * acc[ai][1][m][0], v1 = acc[ai][0][m][1] * acc[ai][1][m][1];
                    u32x4 w; w.x = pk_bf16(v0[0], v0[1]); w.y = pk_bf16(v0[2], v0[3]); w.z = pk_bf16(v1[0], v1[1]); w.w = pk_bf16(v1[2], v1[3]);
                    *(u32x4*)rowp = w; }
        } else {
            if (wc == 0 && fq < 2) {
#pragma unroll
                for (int ai = 0; ai < 2; ++ai)
#pragma unroll
                    for (int m = 0; m < 4; ++m) { float* rowp = GZ + (size_t)(row0 + ai * 128 + m * 16) * 16 + 8 * fq;
                        *(f32x4*)rowp = acc[ai][0][m][0]; *(f32x4*)(rowp + 4) = acc[ai][0][m][1]; }
            }
        }
    }
};
struct EpiUp {
    static constexpr bool PERM = true, AFTER_DRAIN = false;
    bf16_t* O;
    __device__ __forceinline__ void operator()(const f32x4 (&acc)[2][2][4][2], const pg8::Unit& u, int wr, int wc, int fr, int fq) const {
        const int row0 = u.pm * 256 + wr * 64 + fr, col0 = u.pn * 256 + wc * 32 + 8 * fq;
#pragma unroll
        for (int ai = 0; ai < 2; ++ai)
#pragma unroll
            for (int m = 0; m < 4; ++m) { bf16_t* rowp = O + (size_t)(row0 + ai * 128 + m * 16) * FF + col0;
#pragma unroll
                for (int bj = 0; bj < 2; ++bj) { f32x4 v0 = acc[ai][bj][m][0], v1 = acc[ai][bj][m][1];
#pragma unroll
                    for (int j = 0; j < 4; ++j) { const float a = fmaxf(v0[j], 0.f), b = fmaxf(v1[j], 0.f); v0[j] = a * a; v1[j] = b * b; }
                    u32x4 w; w.x = pk_bf16(v0[0], v0[1]); w.y = pk_bf16(v0[2], v0[3]); w.z = pk_bf16(v1[0], v1[1]); w.w = pk_bf16(v1[2], v1[3]);
                    *(u32x4*)(rowp + bj * 128) = w; } }
    }
};
template <bool FROM_X> struct EpiRes {
    static constexpr bool PERM = false, AFTER_DRAIN = false;
    const float* xp; const float* xs; float* Y; const float* gate;
    __device__ __forceinline__ void operator()(const f32x4 (&acc)[2][2][4][2], const pg8::Unit& u, int wr, int wc, int fr, int fq) const {
        const int row0 = u.pm * 256 + wr * 64 + fr, col0 = u.pn * 256 + wc * 32 + 4 * fq;
#pragma unroll
        for (int ai = 0; ai < 2; ++ai)
#pragma unroll
            for (int m = 0; m < 4; ++m) { const int row = row0 + ai * 128 + m * 16; const int bi = batch_of_row(row);
                const float* gp = gate + (size_t)bi * NMOD + col0; float* yp = Y + (size_t)row * D + col0;
                const float* bp = FROM_X ? ((row < MP ? xp + (size_t)row * D : xs + (size_t)(row - MP) * D) + col0) : (const float*)yp;
#pragma unroll
                for (int bj = 0; bj < 2; ++bj)
#pragma unroll
                    for (int n = 0; n < 2; ++n) { const int o = bj * 128 + n * 16; const f32x4 g = *(const f32x4*)(gp + o), b = *(const f32x4*)(bp + o);
                        *(f32x4*)(yp + o) = b + g * acc[ai][bj][m][n]; }
                asm volatile("" ::: "memory"); }
    }
};

struct EpiSlab {
    static constexpr bool PERM = false, AFTER_DRAIN = false;
    float* S; int kslice;
    __device__ __forceinline__ void operator()(const f32x4 (&acc)[2][2][4][2], const pg8::Unit& u, int wr, int wc, int fr, int fq) const {
        const int row0 = u.pm * 256 - MP + wr * 64 + fr, col0 = u.pn * 256 + wc * 32 + 4 * fq; float* base = S + (size_t)(u.kof / kslice) * MS * D;
#pragma unroll
        for (int ai = 0; ai < 2; ++ai)
#pragma unroll
            for (int m = 0; m < 4; ++m) { float* yp = base + (size_t)(row0 + ai * 128 + m * 16) * D + col0;
#pragma unroll
                for (int bj = 0; bj < 2; ++bj)
#pragma unroll
                    for (int n = 0; n < 2; ++n) *(f32x4*)(yp + bj * 128 + n * 16) = acc[ai][bj][m][n]; }
    }
};

__device__ __forceinline__ void tr_item(const float* W, int ldn, int Kdim, int k0, int n0src, int nvalid, bf16_t* WT, int n0dst, LAS float* scr, int lane) {
    const int nn = lane & 31;
    float tv[32];
    const float* wsrc = W + (size_t)(k0 + (lane >> 5)) * ldn + n0src + nn;
#pragma unroll
    for (int i = 0; i < 32; ++i) tv[i] = (nn < nvalid) ? wsrc[(size_t)(2 * i) * ldn] : 0.f;
#pragma unroll
    for (int i = 0; i < 32; ++i) scr[(2 * i + (lane >> 5)) * 33 + nn] = tv[i];
    LDS_WAIT();
    const int c = lane & 7;
#pragma unroll
    for (int j = 0; j < 4; ++j) { const int n = (lane >> 3) + 8 * j; const LAS float* s = scr + (8 * c) * 33 + n;
        u32x4 o; o.x = pk_bf16(s[0 * 33], s[1 * 33]); o.y = pk_bf16(s[2 * 33], s[3 * 33]); o.z = pk_bf16(s[4 * 33], s[5 * 33]); o.w = pk_bf16(s[6 * 33], s[7 * 33]);
        *(u32x4*)(WT + (size_t)(n0dst + n) * Kdim + k0 + 8 * c) = o; }
    LDS_WAIT();
}
__device__ __forceinline__ void win_map(int vc0, int& src, int& nvalid) {
    nvalid = 32;
    if (vc0 < 1024) src = vc0;
    else if (vc0 < 2048) src = vc0 + 16;
    else if (vc0 < 3072) { const int j = (vc0 - 2048) >> 8, w = (vc0 - 2048) & 255; src = (w < 128) ? (2064 + 128 * j + w) : (2576 + 128 * j + (w - 128)); }
    else { src = 1024 + (vc0 - 3072); nvalid = (vc0 == 3072) ? 16 : 0; if (nvalid == 0) src = 0; }
}
__device__ __forceinline__ void phase_prep(const Params& p, LAS unsigned char* lds, int tid, int wave, int lane) {
    const int G = gridDim.x;
    unsigned char* ws = p.ws;
    {
        const float* w_ada = p.in[6]; const float* b_ada = p.in[7]; float* MOD = (float*)(ws + WS_MOD);
        const int fr = lane & 15, fq = lane >> 4, ct = wave & 1, kq = wave >> 1;
        for (int it = blockIdx.x; it < 192; it += G) {
            const int n0 = it * 32;
            f32x4 acc[9];
#pragma unroll
            for (int rt = 0; rt < 9; ++rt) acc[rt] = (f32x4){0.f, 0.f, 0.f, 0.f};
#pragma unroll 1
            for (int kc = 0; kc < 4; ++kc) {
                float wreg[2][8];
#pragma unroll
                for (int s = 0; s < 2; ++s) { const float* wp = w_ada + (size_t)(256 * kc + 32 * (2 * kq + s) + 8 * fq) * NMOD + n0 + 16 * ct + fr;
#pragma unroll
                    for (int j = 0; j < 8; ++j) wreg[s][j] = wp[(size_t)j * NMOD]; }
                __syncthreads();
                for (int idx = tid; idx < 144 * 64; idx += NTHR) { const int r = idx >> 6, k4 = (idx & 63) * 4; f32x4 cv = (f32x4){0.f, 0.f, 0.f, 0.f};
                    if (r < NBATCH) cv = *(const f32x4*)((r < 8 ? p.in[4] + (size_t)r * D : p.in[5] + (size_t)(r - 8) * D) + 256 * kc + k4);
                    u32x2 w; w.x = pk_bf16(silu_f(cv[0]), silu_f(cv[1])); w.y = pk_bf16(silu_f(cv[2]), silu_f(cv[3]));
                    *(LAS u32x2*)(lds + r * 528 + k4 * 2) = w; }
                __syncthreads();
#pragma unroll
                for (int s = 0; s < 2; ++s) {
                    float w8[8];
#pragma unroll
                    for (int j = 0; j < 8; ++j) w8[j] = wreg[s][j];
                    u32x4 bw; bw.x = pk_bf16(w8[0], w8[1]); bw.y = pk_bf16(w8[2], w8[3]); bw.z = pk_bf16(w8[4], w8[5]); bw.w = pk_bf16(w8[6], w8[7]);
                    const bf16x8 Bf = __builtin_bit_cast(bf16x8, bw);
#pragma unroll
                    for (int rt = 0; rt < 9; ++rt) { const bf16x8 Af = *(const LAS bf16x8*)(lds + (16 * rt + fr) * 528 + (32 * (2 * kq + s) + 8 * fq) * 2);
                        acc[rt] = __builtin_amdgcn_mfma_f32_16x16x32_bf16(Af, Bf, acc[rt], 0, 0, 0); }
                }
            }
            __syncthreads();
            LAS float* RED = (LAS float*)lds;
#pragma unroll
            for (int rt = 0; rt < 9; ++rt)
#pragma unroll
                for (int i = 0; i < 4; ++i) RED[((wave * 9 + rt) * 4 + i) * 64 + lane] = acc[rt][i];
            __syncthreads();
#pragma unroll
            for (int e = 0; e < 3; ++e) { const int rt = kq + 4 * e;
                if (rt < 9) {
#pragma unroll
                    for (int i = 0; i < 4; ++i) { const int row = 16 * rt + 4 * fq + i; float s = 0.f;
#pragma unroll
                        for (int q = 0; q < 4; ++q) s += RED[(((q * 2 + ct) * 9 + rt) * 4 + i) * 64 + lane];
                        if (row < NBATCH) MOD[(size_t)row * NMOD + n0 + 16 * ct + fr] = s + b_ada[n0 + 16 * ct + fr]; } } }
        }
        __syncthreads();
    }
    {
        LAS float* scr = (LAS float*)(lds + wave * 16384);
        const int gw = blockIdx.x * NWAVES + wave, NGW = G * NWAVES;
        constexpr int I_IN = 16 * (NIN / 32), I_OUT = 16 * 32, I_UP = 16 * 128, I_DN = 64 * 32;
        for (int it = gw; it < I_IN + I_OUT + I_UP + I_DN; it += NGW) {
            int r = it;
            if (r < I_IN) { const int nb = r % (NIN / 32), kb = r / (NIN / 32); int src, nv; win_map(nb * 32, src, nv);
                tr_item(p.in[9], 3088, D, kb * 64, src, nv, (bf16_t*)(ws + WS_WIN), nb * 32, scr, lane); continue; } r -= I_IN;
            if (r < I_OUT) { const int nb = r % 32, kb = r / 32; tr_item(p.in[14], D, D, kb * 64, nb * 32, 32, (bf16_t*)(ws + WS_WOUT), nb * 32, scr, lane); continue; } r -= I_OUT;
            if (r < I_UP) { const int nb = r % 128, kb = r / 128; tr_item(p.in[16], FF, D, kb * 64, nb * 32, 32, (bf16_t*)(ws + WS_WUP), nb * 32, scr, lane); continue; } r -= I_UP;
            { const int nb = r % 32, kb = r / 32; tr_item(p.in[17], D, FF, kb * 64, nb * 32, 32, (bf16_t*)(ws + WS_WDN), nb * 32, scr, lane); }
        }
    }
}

__device__ __forceinline__ void norm_mod_vals(const f32x4 (&v)[4], const float* g, const float* sc, const float* sh, bf16_t* orow, int lane) {
    float s = 0.f;
#pragma unroll
    for (int j = 0; j < 4; ++j) s += (v[j][0] * v[j][0] + v[j][1] * v[j][1]) + (v[j][2] * v[j][2] + v[j][3] * v[j][3]);
    const float rstd = 1.0f / sqrtf(wave_sum(s) * (1.f / D) + EPS);
    unsigned long long* o8 = (unsigned long long*)orow + lane;
#pragma unroll
    for (int j = 0; j < 4; ++j) { const f32x4 gg = ((const f32x4*)g)[lane + 64 * j], ss = ((const f32x4*)sc)[lane + 64 * j], hh = ((const f32x4*)sh)[lane + 64 * j];
        const f32x4 y = (v[j] * rstd * gg) * (ss + 1.0f) + hh;
        o8[64 * j] = (unsigned long long)pk_bf16(y[0], y[1]) | ((unsigned long long)pk_bf16(y[2], y[3]) << 32); }
}

__device__ __forceinline__ void norm_rows(const float* X, const float* g, const float* MOD, int sc_off, int sh_off, bf16_t* HBo, int gw, int NGW, int lane) {
    if (NGW == MP / 8) {
        const int m0 = gw * 8; const float* md = MOD + (size_t)(m0 >> 11) * NMOD; f32x4 v[8][4], ga[4], sb[4];
#pragma unroll
        for (int r = 0; r < 8; ++r)
#pragma unroll
            for (int j = 0; j < 4; ++j) v[r][j] = ((const f32x4*)(X + (size_t)(m0 + r) * D))[lane + 64 * j];
#pragma unroll
        for (int j = 0; j < 4; ++j) { ga[j] = ((const f32x4*)g)[lane + 64 * j] * (((const f32x4*)(md + sc_off))[lane + 64 * j] + 1.0f); sb[j] = ((const f32x4*)(md + sh_off))[lane + 64 * j]; }
#pragma unroll
        for (int r = 0; r < 8; ++r) { float s = 0.f;
#pragma unroll
            for (int j = 0; j < 4; ++j) s += (v[r][j][0] * v[r][j][0] + v[r][j][1] * v[r][j][1]) + (v[r][j][2] * v[r][j][2] + v[r][j][3] * v[r][j][3]);
            const float rstd = 1.0f / sqrtf(wave_sum(s) * (1.f / D) + EPS);
            unsigned long long* o8 = (unsigned long long*)(HBo + (size_t)(m0 + r) * D) + lane;
#pragma unroll
            for (int j = 0; j < 4; ++j) { const f32x4 y = (v[r][j] * rstd) * ga[j] + sb[j]; o8[64 * j] = (unsigned long long)pk_bf16(y[0], y[1]) | ((unsigned long long)pk_bf16(y[2], y[3]) << 32); } }
        return;
    }
    const int rpw = (MP + NGW - 1) / NGW, m0 = gw * rpw, m1 = (m0 + rpw < MP) ? m0 + rpw : MP;
    if (m0 >= m1) return;
    f32x4 ga[4], sb[4], cur[4], nxt[4]; int cur_bi = -1;
#pragma unroll
    for (int j = 0; j < 4; ++j) cur[j] = ((const f32x4*)(X + (size_t)m0 * D))[lane + 64 * j];
    for (int m = m0; m < m1; ++m) {
        const int bi = m >> 11;
        if (bi != cur_bi) { const float* md = MOD + (size_t)bi * NMOD; cur_bi = bi;
#pragma unroll
            for (int j = 0; j < 4; ++j) { ga[j] = ((const f32x4*)g)[lane + 64 * j] * (((const f32x4*)(md + sc_off))[lane + 64 * j] + 1.0f); sb[j] = ((const f32x4*)(md + sh_off))[lane + 64 * j]; } }
        if (m + 1 < m1) {
#pragma unroll
            for (int j = 0; j < 4; ++j) nxt[j] = ((const f32x4*)(X + (size_t)(m + 1) * D))[lane + 64 * j]; }
        float s = 0.f;
#pragma unroll
        for (int j = 0; j < 4; ++j) s += (cur[j][0] * cur[j][0] + cur[j][1] * cur[j][1]) + (cur[j][2] * cur[j][2] + cur[j][3] * cur[j][3]);
        const float rstd = 1.0f / sqrtf(wave_sum(s) * (1.f / D) + EPS);
        unsigned long long* o8 = (unsigned long long*)(HBo + (size_t)m * D) + lane;
#pragma unroll
        for (int j = 0; j < 4; ++j) { const f32x4 y = (cur[j] * rstd) * ga[j] + sb[j];
            o8[64 * j] = (unsigned long long)pk_bf16(y[0], y[1]) | ((unsigned long long)pk_bf16(y[2], y[3]) << 32); cur[j] = nxt[j]; }
    }
}
template <int NS> __device__ __forceinline__ void slab_row(const float* base, const float* gate, const float* slab, int r, int lane, f32x4 (&v)[4]) {
#pragma unroll
    for (int j = 0; j < 4; ++j) { f32x4 a = ((const f32x4*)(slab + (size_t)r * D))[lane + 64 * j];
#pragma unroll
        for (int ks = 1; ks < NS; ++ks) a += ((const f32x4*)(slab + ((size_t)ks * MS + r) * D))[lane + 64 * j];
        v[j] = ((const f32x4*)base)[lane + 64 * j] + ((const f32x4*)gate)[lane + 64 * j] * a; }
}
__device__ __forceinline__ float gate_ls(const float* gz, const float (&wg)[16], float bgt) {
    float z0 = bgt, z1 = 0.f, z2 = 0.f, z3 = 0.f;
#pragma unroll
    for (int r = 0; r < 4; ++r) { z0 += gz[4 * r] * wg[4 * r]; z1 += gz[4 * r + 1] * wg[4 * r + 1]; z2 += gz[4 * r + 2] * wg[4 * r + 2]; z3 += gz[4 * r + 3] * wg[4 * r + 3]; }
    return logsigmoid_f((z0 + z1) + (z2 + z3)) * (1.0f / 16.0f);
}
__device__ __forceinline__ void gla_decay_item(const Params& p, int it3, int lane) {
    unsigned char* ws = p.ws;
    const int it = it3 >> 1, half = it3 & 1;
    const int b = it >> 7, h = (it >> 5) & 3, c = it & 31, m0 = b * SEQ + c * 64, col = h * 64 + lane;
    const float* GZ = (const float*)(ws + WS_GZ); bf16_t* Q = (bf16_t*)(ws + WS_Q); bf16_t* K = (bf16_t*)(ws + WS_K); bf16_t* KOUT = (bf16_t*)(ws + WS_KOUT);
    float wg[16];
#pragma unroll
    for (int r = 0; r < 16; ++r) wg[r] = p.in[10][r * 256 + col];
    const float bgt = p.in[11][col];
    float last = 0.f, c32 = 0.f;
#pragma unroll 4
    for (int t = 0; t < 64; ++t) { last += gate_ls(GZ + (size_t)(m0 + t) * 16, wg, bgt); if (t == 31) c32 = last; }
    float run = half ? c32 : 0.f;
#pragma unroll 1
    for (int tb = 4 * half; tb < 4 * half + 4; ++tb) {
        float ko[8];
#pragma unroll
        for (int j = 0; j < 8; ++j) { const int t = tb * 8 + j; const size_t o = (size_t)(m0 + t) * 256 + col;
            run += gate_ls(GZ + (size_t)(m0 + t) * 16, wg, bgt);
            const float q = bf2f(Q[o]), k = bf2f(K[o]);
            const float qi = q * __expf(run), ki = k * __expf(-run); ko[j] = k * __expf(last - run);
            Q[o] = (bf16_t)(pk_bf16(qi, 0.f) & 0xffffu); K[o] = (bf16_t)(pk_bf16(ki, 0.f) & 0xffffu); }
        u32x4 w; w.x = pk_bf16(ko[0], ko[1]); w.y = pk_bf16(ko[2], ko[3]); w.z = pk_bf16(ko[4], ko[5]); w.w = pk_bf16(ko[6], ko[7]);
        *(u32x4*)(KOUT + ((size_t)it * 64 + lane) * 64 + tb * 8) = w;
    }
    if (half == 0) ((float*)(ws + WS_DEC))[(size_t)it * 64 + lane] = __expf(last);
}
__device__ __forceinline__ void gla_vt_item(const Params& p, int it2, int lane) {
    unsigned char* ws = p.ws;
    const int it = it2 >> 1, vh = it2 & 1, b = it >> 7, h = (it >> 5) & 3, c = it & 31, m0 = b * SEQ + c * 64, v = vh * 64 + lane;
    const bf16_t* V = (const bf16_t*)(ws + WS_V) + (size_t)m0 * 512 + h * 128 + v; bf16_t* VT = (bf16_t*)(ws + WS_VT) + ((size_t)it * 128 + v) * 64;
#pragma unroll
    for (int sb = 0; sb < 8; ++sb) { unsigned short e[8];
#pragma unroll
        for (int j = 0; j < 8; ++j) e[j] = V[(size_t)(sb * 8 + j) * 512];
        u32x4 w; w.x = e[0] | ((unsigned)e[1] << 16); w.y = e[2] | ((unsigned)e[3] << 16); w.z = e[4] | ((unsigned)e[5] << 16); w.w = e[6] | ((unsigned)e[7] << 16);
        *(u32x4*)(VT + sb * 8) = w; }
}
__device__ __forceinline__ void gla_sample_item(const Params& p, int its, LAS float* L, int lane) {
    unsigned char* ws = p.ws;
    const int b = its >> 2, h = its & 3, mrow = MP + b * DSEQ;
    const float* GZ = (const float*)(ws + WS_GZ); const bf16_t* Q = (const bf16_t*)(ws + WS_Q); const bf16_t* K = (const bf16_t*)(ws + WS_K);
    const bf16_t* V = (const bf16_t*)(ws + WS_V); const bf16_t* R = (const bf16_t*)(ws + WS_R); bf16_t* HB = (bf16_t*)(ws + WS_HB);
    {
        const int col = h * 64 + lane; float wg[16];
#pragma unroll
        for (int r = 0; r < 16; ++r) wg[r] = p.in[10][r * 256 + col];
        const float bgt = p.in[11][col];
#pragma unroll
        for (int t = 0; t < 8; ++t) { const float* gz = GZ + (size_t)(mrow + t) * 16; float z = bgt;
#pragma unroll
            for (int r = 0; r < 16; ++r) z += gz[r] * wg[r];
            const float ld = logsigmoid_f(z) * (1.0f / 16.0f); const size_t o = (size_t)(mrow + t) * 256 + col;
            L[t * 64 + lane] = __expf(ld); L[512 + t * 64 + lane] = bf2f(K[o]); L[1024 + t * 64 + lane] = bf2f(Q[o]); }
        LDS_WAIT();
    }
    const float* S0p = p.in[2] + (size_t)its * 64 * 128; float* So = p.out + O_NGS + (size_t)its * 64 * 128;
#pragma unroll 1
    for (int hf = 0; hf < 2; ++hf) {
        float s0[64];
#pragma unroll
        for (int d = 0; d < 64; ++d) { const float* sp = S0p + hf * 64 + lane + (d >> 3) * 1024; if ((d & 7) == 0) asm volatile("" : "+v"(sp)); s0[d] = sp[(d & 7) * 128]; }
#pragma unroll 1
        for (int t = 0; t < 8; ++t) {
            const float v0 = bf2f(V[(size_t)(mrow + t) * 512 + h * 128 + hf * 64 + lane]); float o0 = 0.f;
#pragma unroll
            for (int d4 = 0; d4 < 16; ++d4) { const f32x4 a = *(const LAS f32x4*)(L + t * 64 + 4 * d4), k = *(const LAS f32x4*)(L + 512 + t * 64 + 4 * d4), q = *(const LAS f32x4*)(L + 1024 + t * 64 + 4 * d4);
#pragma unroll
                for (int j = 0; j < 4; ++j) { const int d = 4 * d4 + j; s0[d] = a[j] * s0[d] + k[j] * v0; o0 += q[j] * s0[d]; } }
            L[1536 + (hf * 8 + t) * 64 + lane] = o0;
        }
#pragma unroll
        for (int d = 0; d < 64; ++d) { float* sp = So + hf * 64 + lane + (d >> 3) * 1024; if ((d & 7) == 0) asm volatile("" : "+v"(sp)); sp[(d & 7) * 128] = s0[d]; }
    }
    LDS_WAIT();
    const float gn0 = p.in[12][h * 128 + lane], gn1 = p.in[12][h * 128 + 64 + lane];
#pragma unroll 1
    for (int t = 0; t < 8; ++t) {
        const float o0 = L[1536 + t * 64 + lane], o1 = L[1536 + (8 + t) * 64 + lane];
        const float rstd = 1.0f / sqrtf(wave_sum(o0 * o0 + o1 * o1) * (1.f / 128.f) + EPS);
        const size_t vo = (size_t)(mrow + t) * 512 + h * 128 + lane;
        const float r0 = bf2f(R[vo]), r1 = bf2f(R[vo + 64]);
        bf16_t* hp = HB + (size_t)(mrow + t) * D + h * 128 + lane;
        hp[0] = (bf16_t)(pk_bf16(o0 * rstd * gn0 * r0, 0.f) & 0xffffu); hp[64] = (bf16_t)(pk_bf16(o1 * rstd * gn1 * r1, 0.f) & 0xffffu);
    }
    LDS_WAIT();
}
__device__ __forceinline__ void conv_row(const Params& p, int m, int lane) {
    unsigned char* ws = p.ws;
    const bf16_t* U = (const bf16_t*)(ws + WS_U); const bf16_t* BG = (const bf16_t*)(ws + WS_BG); bf16_t* HB = (bf16_t*)(ws + WS_HB);
    const int ch = 8 * lane; const bool prompt = m < MP; const int t = prompt ? (m & (SEQ - 1)) : ((m - MP) & (DSEQ - 1)); const int b = prompt ? (m >> 11) : ((m - MP) >> 3);
    const int L = prompt ? SEQ : DSEQ;
    float u0[8], u1[8], u2[8], bg[8];
    { const u32x4 w = *(const u32x4*)(U + (size_t)m * 512 + ch); const u32x4 g = *(const u32x4*)(BG + (size_t)m * 512 + ch);
#pragma unroll
      for (int j = 0; j < 4; ++j) { u0[2 * j] = __uint_as_float(w[j] << 16); u0[2 * j + 1] = __uint_as_float(w[j] & 0xffff0000u); bg[2 * j] = __uint_as_float(g[j] << 16); bg[2 * j + 1] = __uint_as_float(g[j] & 0xffff0000u); } }
    const float* st = p.in[3] + (size_t)b * 2 * 512 + ch;
    if (t >= 1) { const u32x4 w = *(const u32x4*)(U + (size_t)(m - 1) * 512 + ch);
#pragma unroll
        for (int j = 0; j < 4; ++j) { u1[2 * j] = __uint_as_float(w[j] << 16); u1[2 * j + 1] = __uint_as_float(w[j] & 0xffff0000u); } }
    else {
#pragma unroll
        for (int j = 0; j < 8; ++j) u1[j] = prompt ? 0.f : st[512 + j]; }
    if (t >= 2) { const u32x4 w = *(const u32x4*)(U + (size_t)(m - 2) * 512 + ch);
#pragma unroll
        for (int j = 0; j < 4; ++j) { u2[2 * j] = __uint_as_float(w[j] << 16); u2[2 * j + 1] = __uint_as_float(w[j] & 0xffff0000u); } }
    else {
#pragma unroll
        for (int j = 0; j < 8; ++j) u2[j] = prompt ? 0.f : st[(t == 1 ? 512 : 0) + j]; }
    const float* wc = p.in[13] + ch; float y[8];
#pragma unroll
    for (int j = 0; j < 8; ++j) y[j] = bg[j] * (wc[j] * u2[j] + wc[512 + j] * u1[j] + wc[1024 + j] * u0[j]);
    u32x4 o; o.x = pk_bf16(y[0], y[1]); o.y = pk_bf16(y[2], y[3]); o.z = pk_bf16(y[4], y[5]); o.w = pk_bf16(y[6], y[7]);
    *(u32x4*)(HB + (size_t)m * D + 512 + ch) = o;
    if (t == L - 1) { float* nc = p.out + (prompt ? O_NCP : O_NCS) + (size_t)b * 2 * 512 + ch;
#pragma unroll
        for (int j = 0; j < 8; ++j) { nc[j] = u1[j]; nc[512 + j] = u0[j]; } }
}
__device__ __forceinline__ void gla_sloc_item(const Params& p, int it2, int lane) {
    unsigned char* ws = p.ws;
    const int it = it2 >> 1, vh = it2 & 1, fr = lane & 15, fq = lane >> 4;
    const bf16_t* VT = (const bf16_t*)(ws + WS_VT) + ((size_t)it * 128 + vh * 64) * 64; const bf16_t* KO = (const bf16_t*)(ws + WS_KOUT) + (size_t)it * 64 * 64;
    f32x4 acc[4][4];
#pragma unroll
    for (int a = 0; a < 4; ++a)
#pragma unroll
        for (int b = 0; b < 4; ++b) acc[a][b] = (f32x4){0.f, 0.f, 0.f, 0.f};
#pragma unroll
    for (int ks = 0; ks < 2; ++ks) { bf16x8 A[4], B[4];
#pragma unroll
        for (int i = 0; i < 4; ++i) { A[i] = *(const bf16x8*)(KO + (size_t)(16 * i + fr) * 64 + 32 * ks + 8 * fq); B[i] = *(const bf16x8*)(VT + (size_t)(16 * i + fr) * 64 + 32 * ks + 8 * fq); }
#pragma unroll
        for (int a = 0; a < 4; ++a)
#pragma unroll
            for (int b = 0; b < 4; ++b) acc[a][b] = __builtin_amdgcn_mfma_f32_16x16x32_bf16(A[a], B[b], acc[a][b], 0, 0, 0); }
    bf16_t* SL = (bf16_t*)(ws + WS_SLOC) + ((size_t)it * 128 + vh * 64) * 64;
#pragma unroll
    for (int a = 0; a < 4; ++a)
#pragma unroll
        for (int b = 0; b < 4; ++b) { u32x2 w; w.x = pk_bf16(acc[a][b][0], acc[a][b][1]); w.y = pk_bf16(acc[a][b][2], acc[a][b][3]);
            *(u32x2*)(SL + (size_t)(16 * b + fr) * 64 + 16 * a + 4 * fq) = w; }
}
__device__ __forceinline__ void gla_scan(const Params& p, int tid) {
    unsigned char* ws = p.ws;
    u32x2* SL = (u32x2*)(ws + WS_SLOC); const f32x4* DEC = (const f32x4*)(ws + WS_DEC);
    for (int idx = blockIdx.x * NTHR + tid; idx < 32 * 128 * 16; idx += gridDim.x * NTHR) {
        const int bh = idx >> 11, v = (idx >> 4) & 127, d4 = idx & 15;
        f32x4 S = (f32x4){0.f, 0.f, 0.f, 0.f};
#pragma unroll 8
        for (int c = 0; c < 32; ++c) { const size_t o = ((size_t)(bh * 32 + c) * 128 + v) * 16 + d4; const u32x2 tw = SL[o]; const f32x4 dc = DEC[(size_t)(bh * 32 + c) * 16 + d4];
            const f32x4 t = (f32x4){__uint_as_float(tw.x << 16), __uint_as_float(tw.x & 0xffff0000u), __uint_as_float(tw.y << 16), __uint_as_float(tw.y & 0xffff0000u)};
            u32x2 sw; sw.x = pk_bf16(S[0], S[1]); sw.y = pk_bf16(S[2], S[3]); SL[o] = sw; S = dc * S + t; }
        float* ng = p.out + O_NGP + (size_t)bh * 64 * 128 + v;
#pragma unroll
        for (int i = 0; i < 4; ++i) ng[(size_t)(4 * d4 + i) * 128] = S[i];
    }
}
__device__ __forceinline__ void gla_out_item(const Params& p, int it2, int lane) {
    unsigned char* ws = p.ws;
    const int it = it2 >> 1, th = it2 & 1, fr = lane & 15, fq = lane >> 4;
    const int b = it >> 7, h = (it >> 5) & 3, c = it & 31, m0 = b * SEQ + c * 64;
    const bf16_t* Q = (const bf16_t*)(ws + WS_Q) + (size_t)m0 * 256 + h * 64; const bf16_t* K = (const bf16_t*)(ws + WS_K) + (size_t)m0 * 256 + h * 64;
    const bf16_t* VT = (const bf16_t*)(ws + WS_VT) + (size_t)it * 128 * 64; const bf16_t* ST = (const bf16_t*)(ws + WS_SLOC) + (size_t)it * 128 * 64;
    bf16x8 Bq[2][2];
#pragma unroll
    for (int tt = 0; tt < 2; ++tt)
#pragma unroll
        for (int ks = 0; ks < 2; ++ks) Bq[tt][ks] = *(const bf16x8*)(Q + (size_t)(32 * th + 16 * tt + fr) * 256 + 32 * ks + 8 * fq);
    u32x2 P[4][2];
#pragma unroll
    for (int st = 0; st < 4; ++st) {
        if (st < 2 + 2 * th) {
            f32x4 a0 = (f32x4){0.f, 0.f, 0.f, 0.f}, a1 = a0;
#pragma unroll
            for (int ks = 0; ks < 2; ++ks) { const bf16x8 Ak = *(const bf16x8*)(K + (size_t)(16 * st + fr) * 256 + 32 * ks + 8 * fq);
                a0 = __builtin_amdgcn_mfma_f32_16x16x32_bf16(Ak, Bq[0][ks], a0, 0, 0, 0); a1 = __builtin_amdgcn_mfma_f32_16x16x32_bf16(Ak, Bq[1][ks], a1, 0, 0, 0); }
            const int t0 = 32 * th + fr, t1 = t0 + 16;
#pragma unroll
            for (int i = 0; i < 4; ++i) { const int s = 16 * st + 4 * fq + i; a0[i] = (s <= t0) ? a0[i] : 0.f; a1[i] = (s <= t1) ? a1[i] : 0.f; }
            P[st][0].x = pk_bf16(a0[0], a0[1]); P[st][0].y = pk_bf16(a0[2], a0[3]); P[st][1].x = pk_bf16(a1[0], a1[1]); P[st][1].y = pk_bf16(a1[2], a1[3]);
        } else { P[st][0] = (u32x2){0u, 0u}; P[st][1] = (u32x2){0u, 0u}; }
    }
    f32x4 acc[8][2];
#pragma unroll
    for (int vt = 0; vt < 8; ++vt) { acc[vt][0] = (f32x4){0.f, 0.f, 0.f, 0.f}; acc[vt][1] = acc[vt][0]; }
#pragma unroll
    for (int kp = 0; kp < 2; ++kp) {
        if (kp < 1 + th) {
            bf16x8 Bp[2];
#pragma unroll
            for (int tt = 0; tt < 2; ++tt) { u32x4 w; w.x = P[2 * kp][tt].x; w.y = P[2 * kp][tt].y; w.z = P[2 * kp + 1][tt].x; w.w = P[2 * kp + 1][tt].y; Bp[tt] = __builtin_bit_cast(bf16x8, w); }
#pragma unroll
            for (int vt = 0; vt < 8; ++vt) { const bf16_t* vp = VT + (size_t)(16 * vt + fr) * 64 + 32 * kp + 4 * fq;
                const u32x2 lo = *(const u32x2*)vp, hi = *(const u32x2*)(vp + 16); u32x4 w; w.x = lo.x; w.y = lo.y; w.z = hi.x; w.w = hi.y; const bf16x8 Av = __builtin_bit_cast(bf16x8, w);
                acc[vt][0] = __builtin_amdgcn_mfma_f32_16x16x32_bf16(Av, Bp[0], acc[vt][0], 0, 0, 0); acc[vt][1] = __builtin_amdgcn_mfma_f32_16x16x32_bf16(Av, Bp[1], acc[vt][1], 0, 0, 0); }
        }
    }
#pragma unroll
    for (int ks = 0; ks < 2; ++ks)
#pragma unroll
        for (int vt = 0; vt < 8; ++vt) { const bf16x8 As = *(const bf16x8*)(ST + (size_t)(16 * vt + fr) * 64 + 32 * ks + 8 * fq);
            acc[vt][0] = __builtin_amdgcn_mfma_f32_16x16x32_bf16(As, Bq[0][ks], acc[vt][0], 0, 0, 0); acc[vt][1] = __builtin_amdgcn_mfma_f32_16x16x32_bf16(As, Bq[1][ks], acc[vt][1], 0, 0, 0); }
    const bf16_t* R = (const bf16_t*)(ws + WS_R); bf16_t* HB = (bf16_t*)(ws + WS_HB); const float* gn = p.in[12] + h * 128;
#pragma unroll
    for (int tt = 0; tt < 2; ++tt) { float ss = 0.f;
#pragma unroll
        for (int vt = 0; vt < 8; ++vt) ss += (acc[vt][tt][0] * acc[vt][tt][0] + acc[vt][tt][1] * acc[vt][tt][1]) + (acc[vt][tt][2] * acc[vt][tt][2] + acc[vt][tt][3] * acc[vt][tt][3]);
        ss += __shfl_xor(ss, 16); ss += __shfl_xor(ss, 32);
        const float rstd = 1.0f / sqrtf(ss * (1.f / 128.f) + EPS);
        const int mrow = m0 + 32 * th + 16 * tt + fr;
#pragma unroll
        for (int vt = 0; vt < 8; ++vt) { const int v = 16 * vt + 4 * fq; const f32x4 g4 = *(const f32x4*)(gn + v); const u32x2 rw = *(const u32x2*)(R + (size_t)mrow * 512 + h * 128 + v);
            const float r0 = __uint_as_float(rw.x << 16), r1 = __uint_as_float(rw.x & 0xffff0000u), r2 = __uint_as_float(rw.y << 16), r3 = __uint_as_float(rw.y & 0xffff0000u);
            const f32x4 o = acc[vt][tt] * rstd * g4;
            u32x2 w; w.x = pk_bf16(o[0] * r0, o[1] * r1); w.y = pk_bf16(o[2] * r2, o[3] * r3);
            *(u32x2*)(HB + (size_t)mrow * D + h * 128 + v) = w; }
    }
}

#define RLX_AGENT __ATOMIC_RELAXED, __HIP_MEMORY_SCOPE_AGENT
#define XB_TMO      128
#define XB_XCNT(j)  (256  + 64 * (j))
#define XB_XSUB(j)  (1280 + 64 * (j))
#define XB_XGEN(j)  (2304 + 64 * (j))
#define XB_TOP      3328
#define XB_TOPGEN   3392
#define XCD_BAR_WORDS 3456
#define XB_SPIN_CAP (1u << 18)

__device__ __forceinline__ unsigned xb_ld(unsigned* p)              { return __hip_atomic_load(p, __ATOMIC_RELAXED, __HIP_MEMORY_SCOPE_AGENT); }
__device__ __forceinline__ unsigned xb_add(unsigned* p, unsigned v) { return __hip_atomic_fetch_add(p, v, __ATOMIC_RELAXED, __HIP_MEMORY_SCOPE_AGENT); }
__device__ __forceinline__ unsigned xb_xcc_id() { return (unsigned)__builtin_amdgcn_s_getreg((3 << 11) | 20) & 0xFu; }
#define XB_SPIN(cond, bar) do { unsigned _sp = 0; while (cond) { __builtin_amdgcn_s_sleep(1); \
    if ((++_sp & 255u) == 0u) { if (xb_ld(&(bar)[XB_TMO])) break; if (_sp > XB_SPIN_CAP) { atomicAdd(&(bar)[XB_TMO], 1u); break; } } } } while (0)

struct XcdBarrier {
    unsigned* bar; unsigned x;
    volatile LAS unsigned* st;
};

__device__ __forceinline__ XcdBarrier xcd_barrier_post(unsigned* bar, volatile LAS unsigned* st) {
    XcdBarrier b; b.bar = bar; b.x = xb_xcc_id(); b.st = st;
    if (threadIdx.x == 0) (void)xb_add(&bar[XB_XCNT(b.x)], 1u);
    return b;
}
__device__ __forceinline__ void xcd_barrier_complete(unsigned* bar, unsigned x, unsigned& nloc, unsigned& nx) {
    const unsigned G = gridDim.x * gridDim.y * gridDim.z;
    unsigned sum, cnt, mine, sp = 0u;
    for (;;) {
        sum = 0u; cnt = 0u; mine = 0u;
#pragma unroll
        for (unsigned j = 0; j < 16; ++j) { const unsigned c = xb_ld(&bar[XB_XCNT(j)]); sum += c; cnt += (c > 0u) ? 1u : 0u; mine = (j == x) ? c : mine; }
        if (sum == G) break;
        __builtin_amdgcn_s_sleep(1);
        if ((++sp & 255u) == 0u) { if (xb_ld(&bar[XB_TMO])) break; if (sp > XB_SPIN_CAP) { atomicAdd(&bar[XB_TMO], 1u); break; } }
    }
    nloc = mine > 0u ? mine : 1u; nx = cnt > 0u ? cnt : 1u;
}

__device__ __forceinline__ void xcd_barrier(const XcdBarrier& b) {
    asm volatile("s_waitcnt vmcnt(0)" ::: "memory");
    __syncthreads();
    if (threadIdx.x == 0) {
        unsigned* bar = b.bar;
        __builtin_amdgcn_s_waitcnt(0);
        unsigned nloc = b.st[0], nx = b.st[1];
        if (nloc == 0u) { xcd_barrier_complete(bar, b.x, nloc, nx); b.st[0] = nloc; b.st[1] = nx; }
        const unsigned old = xb_add(&bar[XB_XSUB(b.x)], 1u);
        const unsigned gen = old / nloc;
        if (old + 1u == (gen + 1u) * nloc) {
            __builtin_amdgcn_fence(__ATOMIC_RELEASE, "agent");
            asm volatile("s_waitcnt vmcnt(0)" ::: "memory");
            const unsigned og = xb_add(&bar[XB_TOP], 1u);
            const unsigned tg = og / nx;
            if (og + 1u == (tg + 1u) * nx) xb_add(&bar[XB_TOPGEN], 1u);
            else XB_SPIN(xb_ld(&bar[XB_TOPGEN]) == tg, bar);
            __builtin_amdgcn_fence(__ATOMIC_ACQUIRE, "agent");
            xb_add(&bar[XB_XGEN(b.x)], 1u);
            asm volatile("s_waitcnt vmcnt(0)" ::: "memory");
        } else {
            XB_SPIN(xb_ld(&bar[XB_XGEN(b.x)]) == gen, bar);
            __builtin_amdgcn_fence(__ATOMIC_ACQUIRE, "agent");
            asm volatile("s_waitcnt vmcnt(0)" ::: "memory");
        }
    }
    __syncthreads();
}

#ifndef MK_SKIP
#define MK_SKIP 0
#endif
__global__ void __launch_bounds__(NTHR, 2) mk_fwd(Params p) {
    extern __shared__ __attribute__((aligned(16))) unsigned char lds_raw[];
    LAS unsigned char* lds = (LAS unsigned char*)lds_raw;
    cg::grid_group grid = cg::this_grid();
    const int tid = threadIdx.x, lane = tid & 63, wave = __builtin_amdgcn_readfirstlane(tid >> 6);
    const int G = gridDim.x, gw = blockIdx.x * NWAVES + wave, NGW = G * NWAVES;
    unsigned char* ws = p.ws;
    float* MOD = (float*)(ws + WS_MOD); bf16_t* HB = (bf16_t*)(ws + WS_HB); float* Y = p.out + O_Y;
    const int lo = p.ph_lo, hi = p.ph_hi;
    if (tid < 64) ((LAS unsigned*)(lds + LDS_CTL_OFF))[tid] = 0u;
    __syncthreads();
    XcdBarrier bar = xcd_barrier_post((unsigned*)ws, (volatile LAS unsigned*)(lds + LDS_CTL_OFF));
    if (lo < 0) grid.sync();
#define IN(k) (lo <= (k) && (k) < hi)
#define SEAM(k) do { if (IN(k) && IN((k) + 1)) xcd_barrier(bar); } while (0)

    if (IN(0) && !(MK_SKIP & (1 << 0))) phase_prep(p, lds, tid, wave, lane);
    SEAM(0);
    if (IN(1) && !(MK_SKIP & (1 << 1))) {
        norm_rows(p.in[0], p.in[8], MOD, 1024, 0, HB, gw, NGW, lane);
        for (int m = MP + gw; m < M; m += NGW) { const float* md = MOD + (size_t)batch_of_row(m) * NMOD; f32x4 v[4];
#pragma unroll
            for (int j = 0; j < 4; ++j) v[j] = ((const f32x4*)(p.in[1] + (size_t)(m - MP) * D))[lane + 64 * j];
            norm_mod_vals(v, p.in[8], md + 1024, md, HB + (size_t)m * D, lane); }
    }
    SEAM(1);
    if (IN(2) && !(MK_SKIP & (1 << 2))) {
        pg8::Gemm g{HB, (const bf16_t*)(ws + WS_WIN), M, NIN, D, D}; pg8::StaticOrder S; S.init(M, NIN, G, (int)blockIdx.x);
        EpiIn E{(bf16_t*)(ws + WS_Q), (bf16_t*)(ws + WS_K), (bf16_t*)(ws + WS_V), (bf16_t*)(ws + WS_R), (bf16_t*)(ws + WS_BG), (bf16_t*)(ws + WS_U), (float*)(ws + WS_GZ)};
        pg8::gemm_phase<EpiIn, pg8::StaticOrder, true, true>(lds, g, S, E);
    }
    SEAM(2);
    if (IN(3) && !(MK_SKIP & (1 << 3))) {
        LAS float* L = (LAS float*)(lds + wave * 16384);
        constexpr int N_DEC = 2048, N_VT = 2048, N_SMP = 512;
        for (int it = gw; it < N_DEC + N_VT + N_SMP + M; it += NGW) {
            int r = it;
            if (r < N_DEC) { gla_decay_item(p, r, lane); continue; } r -= N_DEC;
            if (r < N_VT) { gla_vt_item(p, r, lane); continue; } r -= N_VT;
            if (r < N_SMP) { gla_sample_item(p, r, L, lane); continue; } r -= N_SMP;
            conv_row(p, r, lane);
        }
    }
    SEAM(3);
    if (IN(4) && !(MK_SKIP & (1 << 4))) { for (int it = gw; it < 2048; it += NGW) gla_sloc_item(p, it, lane); }
    SEAM(4);
    if (IN(5) && !(MK_SKIP & (1 << 5))) gla_scan(p, tid);
    SEAM(5);
    if (IN(6) && !(MK_SKIP & (1 << 6))) { for (int it = gw; it < 2048; it += NGW) gla_out_item(p, it, lane); }
    SEAM(6);
    if (IN(7) && !(MK_SKIP & (1 << 7))) {
        { pg8::Gemm g{HB, (const bf16_t*)(ws + WS_WOUT), MP, D, D, D}; pg8::StaticOrder S; S.init(MP, D, G, (int)blockIdx.x);
          EpiRes<true> E{p.in[0], p.in[1], Y, MOD + 2048};
          pg8::gemm_phase<EpiRes<true>, pg8::StaticOrder, true, true>(lds, g, S, E); }
        { pg8::Gemm g{HB, (const bf16_t*)(ws + WS_WOUT), M, D, 256, D}; pg8::SplitOrder S; S.init(MP / 256, MS / 256, D / 256, 4, 256, G, (int)blockIdx.x);
          EpiSlab E{(float*)(ws + WS_SLAB), 256};
          pg8::gemm_phase<EpiSlab, pg8::SplitOrder, true, true>(lds, g, S, E); }
    }
    SEAM(7);
    if (IN(8) && !(MK_SKIP & (1 << 8))) {
        norm_rows(Y, p.in[15], MOD, 4096, 3072, HB, gw, NGW, lane);
        for (int m = MP + gw; m < M; m += NGW) { const float* md = MOD + (size_t)batch_of_row(m) * NMOD; f32x4 v[4];
            slab_row<4>(p.in[1] + (size_t)(m - MP) * D, md + 2048, (const float*)(ws + WS_SLAB), m - MP, lane, v);
#pragma unroll
            for (int j = 0; j < 4; ++j) ((f32x4*)(Y + (size_t)m * D))[lane + 64 * j] = v[j];
            norm_mod_vals(v, p.in[15], md + 4096, md + 3072, HB + (size_t)m * D, lane); }
    }
    SEAM(8);
    if (IN(9) && !(MK_SKIP & (1 << 9))) {
        pg8::Gemm g{HB, (const bf16_t*)(ws + WS_WUP), M, FF, D, D}; pg8::StaticOrder S; S.init(M, FF, G, (int)blockIdx.x);
        EpiUp E{(bf16_t*)(ws + WS_ACT)};
        pg8::gemm_phase<EpiUp, pg8::StaticOrder, true, true>(lds, g, S, E);
    }
    SEAM(9);
    if (IN(10) && !(MK_SKIP & (1 << 10))) {
        { pg8::Gemm g{(const bf16_t*)(ws + WS_ACT), (const bf16_t*)(ws + WS_WDN), MP, D, FF, FF}; pg8::StaticOrder S; S.init(MP, D, G, (int)blockIdx.x);
          EpiRes<false> E{nullptr, nullptr, Y, MOD + 5120};
          pg8::gemm_phase<EpiRes<false>, pg8::StaticOrder, true, true>(lds, g, S, E); }
        { pg8::Gemm g{(const bf16_t*)(ws + WS_ACT), (const bf16_t*)(ws + WS_WDN), M, D, 512, FF}; pg8::SplitOrder S; S.init(MP / 256, MS / 256, D / 256, 8, 512, G, (int)blockIdx.x);
          EpiSlab E{(float*)(ws + WS_SLAB), 512};
          pg8::gemm_phase<EpiSlab, pg8::SplitOrder, true, true>(lds, g, S, E); }
    }
    SEAM(10);
    if (IN(11) && !(MK_SKIP & (1 << 11))) {
        const float* fg = p.in[18];
        f32x4 fg4[4];
#pragma unroll
        for (int j = 0; j < 4; ++j) fg4[j] = ((const f32x4*)fg)[lane + 64 * j];
        if (NGW == MP / 8) {
            const int m0 = gw * 8; f32x4 v[8][4];
#pragma unroll
            for (int r = 0; r < 8; ++r)
#pragma unroll
                for (int j = 0; j < 4; ++j) v[r][j] = ((const f32x4*)(Y + (size_t)(m0 + r) * D))[lane + 64 * j];
#pragma unroll
            for (int r = 0; r < 8; ++r) { float s = 0.f;
#pragma unroll
                for (int j = 0; j < 4; ++j) s += (v[r][j][0] * v[r][j][0] + v[r][j][1] * v[r][j][1]) + (v[r][j][2] * v[r][j][2] + v[r][j][3] * v[r][j][3]);
                const float rstd = 1.0f / sqrtf(wave_sum(s) * (1.f / D) + EPS);
#pragma unroll
                for (int j = 0; j < 4; ++j) ((f32x4*)(Y + (size_t)(m0 + r) * D))[lane + 64 * j] = v[r][j] * rstd * fg4[j]; }
        } else {
            const int rpw = (MP + NGW - 1) / NGW, m0 = gw * rpw, m1 = (m0 + rpw < MP) ? m0 + rpw : MP;
            f32x4 cur[4], nxt[4];
            if (m0 < m1) {
#pragma unroll
                for (int j = 0; j < 4; ++j) cur[j] = ((const f32x4*)(Y + (size_t)m0 * D))[lane + 64 * j]; }
            for (int m = m0; m < m1; ++m) {
                if (m + 1 < m1) {
#pragma unroll
                    for (int j = 0; j < 4; ++j) nxt[j] = ((const f32x4*)(Y + (size_t)(m + 1) * D))[lane + 64 * j]; }
                float s = 0.f;
#pragma unroll
                for (int j = 0; j < 4; ++j) s += (cur[j][0] * cur[j][0] + cur[j][1] * cur[j][1]) + (cur[j][2] * cur[j][2] + cur[j][3] * cur[j][3]);
                const float rstd = 1.0f / sqrtf(wave_sum(s) * (1.f / D) + EPS);
#pragma unroll
                for (int j = 0; j < 4; ++j) { ((f32x4*)(Y + (size_t)m * D))[lane + 64 * j] = cur[j] * rstd * fg4[j]; cur[j] = nxt[j]; }
            }
        }
        for (int m = MP + gw; m < M; m += NGW) { f32x4 v[4]; float s = 0.f;
            slab_row<8>(Y + (size_t)m * D, MOD + (size_t)batch_of_row(m) * NMOD + 5120, (const float*)(ws + WS_SLAB), m - MP, lane, v);
#pragma unroll
            for (int j = 0; j < 4; ++j) s += (v[j][0] * v[j][0] + v[j][1] * v[j][1]) + (v[j][2] * v[j][2] + v[j][3] * v[j][3]);
            const float rstd = 1.0f / sqrtf(wave_sum(s) * (1.f / D) + EPS);
#pragma unroll
            for (int j = 0; j < 4; ++j) ((f32x4*)(Y + (size_t)m * D))[lane + 64 * j] = v[j] * rstd * fg4[j]; }
    }
#undef IN
#undef SEAM
}

#ifndef MK_SPLIT

#define MK_SPLIT 0
#endif
constexpr int N_PHASES = 12;
extern "C" void kernel_launch(void* const* d_in, const int* in_sizes, int n_in, void* d_out, int out_size, void* d_ws, size_t ws_size, hipStream_t stream) {
    static int grid = 0;
    if (grid == 0) {
        int dev = 0, cus = 0, per_cu = 0;
        if (hipGetDevice(&dev) != hipSuccess || hipDeviceGetAttribute(&cus, hipDeviceAttributeMultiprocessorCount, dev) != hipSuccess) { fprintf(stderr, "kernel_launch: device query failed\n"); grid = -1; return; }
        if (hipFuncSetAttribute((const void*)mk_fwd, hipFuncAttributeMaxDynamicSharedMemorySize, LDS_BYTES) != hipSuccess) { fprintf(stderr, "kernel_launch: hipFuncSetAttribute failed\n"); grid = -1; return; }
        if (hipOccupancyMaxActiveBlocksPerMultiprocessor(&per_cu, (const void*)mk_fwd, NTHR, LDS_BYTES) != hipSuccess || per_cu < 1) { fprintf(stderr, "kernel_launch: occupancy query says %d\n", per_cu); per_cu = 1; }
        (void)hipGetLastError();
        grid = cus;
        if (n_in != 19 || ws_size < WS_END || (size_t)ws_size < WS_ACT + (size_t)M * FF * 2) { fprintf(stderr, "kernel_launch: unexpected n_in %d / ws %zu\n", n_in, ws_size); grid = -1; return; }
    }
    if (grid < 0) return;
    if (hipMemsetAsync(d_ws, 0, 16384, stream) != hipSuccess) { fprintf(stderr, "kernel_launch: memset failed\n"); return; }
    Params p{};
    for (int i = 0; i < 19; ++i) p.in[i] = (const float*)d_in[i];
    p.out = (float*)d_out; p.ws = (unsigned char*)d_ws;
#if MK_SPLIT
    for (int ph = 0; ph < N_PHASES; ++ph) { p.ph_lo = ph; p.ph_hi = ph + 1; hipLaunchKernelGGL(mk_fwd, dim3(grid), dim3(NTHR), LDS_BYTES, stream, p); }
#else
    p.ph_lo = 0; p.ph_hi = N_PHASES;
    void* args[] = {&p};
    hipError_t e = hipLaunchCooperativeKernel((const void*)mk_fwd, dim3(grid), dim3(NTHR), args, LDS_BYTES, stream);
    if (e != hipSuccess) fprintf(stderr, "kernel_launch: cooperative launch failed: %s (grid %d)\n", hipGetErrorString(e), grid);
#endif
}
```
